# Optimizing an MI355X kernel written in HIP

```python
import math
import jax, jax.numpy as jnp
from jax import lax
import numpy as np

D_MODEL = 1024
BATCH = 16
SEQ = 256
DEPTH = 2
DEC_BATCH = 2
DEC_SEQ = 2048
PAST_LEN = 256

GRID_W = 64
ROPE_BASE = 10000.0
CONV_W = 512
CONV_K = 31
DIFF_HEADS = 4
DIFF_HD = 64
DIFF_W = DIFF_HEADS * 2 * DIFF_HD
MLA_HEADS = 8
MLA_NOPE = 64
MLA_ROPE = 32
MLA_QK = MLA_NOPE + MLA_ROPE
MLA_V = 64
MLA_Q_RANK = 384
MLA_KV_RANK = 256
MLA_W = MLA_HEADS * MLA_V
N_BRANCH = 3
D_FF = 4 * D_MODEL
IN_COLS = 2 * CONV_W + 3 * DIFF_W + MLA_Q_RANK + MLA_KV_RANK + MLA_ROPE + N_BRANCH * D_MODEL
Q_BLOCK = 128
EPS = 1e-6

kernel_name = 'hybrid_diffusion_conformer_diffattn_mla_step'


def _rms(x, g):
    xf = x.astype(jnp.float32)
    y = xf * lax.rsqrt(jnp.mean(xf * xf, axis=-1, keepdims=True) + EPS)
    return (y * g.astype(jnp.float32)).astype(x.dtype)


def _split_points():
    sizes = (2 * CONV_W, DIFF_W, DIFF_W, DIFF_W, MLA_Q_RANK, MLA_KV_RANK, MLA_ROPE)
    pts, acc = [], 0
    for s in sizes:
        acc += s
        pts.append(acc)
    return pts


def _axial_tables(seq_len, rot_dim):
    rows = seq_len // GRID_W
    row = jnp.repeat(jnp.arange(rows, dtype=jnp.float32), GRID_W)
    col = jnp.tile(jnp.arange(GRID_W, dtype=jnp.float32), rows)
    half = rot_dim // 2
    inv = ROPE_BASE ** (-jnp.arange(0, half, 2, dtype=jnp.float32) / half)
    ang = jnp.stack([row[:, None] * inv, col[:, None] * inv], axis=1)
    return jnp.cos(ang), jnp.sin(ang)


def _rope2d(x, tables):
    cos, sin = tables
    qd = x.shape[-1] // 4
    xr = x.reshape(x.shape[:-1] + (2, 2, qd)).astype(jnp.float32)
    x1, x2 = xr[..., 0, :], xr[..., 1, :]
    shape = (1, cos.shape[0]) + (1,) * (x.ndim - 3) + (2, qd)
    c = cos.reshape(shape)
    s = sin.reshape(shape)
    out = jnp.stack([x1 * c - x2 * s, x2 * c + x1 * s], axis=-2)
    return out.reshape(x.shape).astype(x.dtype)


def _sweep_queries(core, q):
    b, sq = q.shape[:2]
    nb = sq // Q_BLOCK
    qb = jnp.moveaxis(q.reshape((b, nb, Q_BLOCK) + q.shape[2:]), 1, 0)
    out = lax.map(core, qb)
    return jnp.moveaxis(out, 0, 1).reshape((b, sq) + out.shape[3:])


def _diff_attend(q, k, v, lam):
    scale = DIFF_HD ** -0.5
    def core(qb):
        s = jnp.einsum('bqhcd,bkhcd->bchqk', qb, k).astype(jnp.float32) * scale
        a = jax.nn.softmax(s, axis=-1)
        w = a[:, 0] - lam * a[:, 1]
        return jnp.einsum('bhqk,bkhe->bqhe', w.astype(v.dtype), v)
    return _sweep_queries(core, q)


def _mla_attend(q, k, v):
    scale = MLA_QK ** -0.5
    def core(qb):
        s = jnp.einsum('bqhd,bkhd->bhqk', qb, k).astype(jnp.float32) * scale
        a = jax.nn.softmax(s, axis=-1)
        return jnp.einsum('bhqk,bkhe->bqhe', a.astype(v.dtype), v)
    return _sweep_queries(core, q)


def _mla_expand(ckv, kpe, w_ukv, k_norm):
    b, l, _ = ckv.shape
    kv = (ckv @ w_ukv).reshape(b, l, MLA_HEADS, MLA_NOPE + MLA_V)
    k_nope, v = kv[..., :MLA_NOPE], kv[..., MLA_NOPE:]
    k = jnp.concatenate([k_nope, jnp.broadcast_to(kpe[:, :, None, :], (b, l, MLA_HEADS, MLA_ROPE))], axis=-1)
    return _rms(k, k_norm), v


def _conv_module(u, dw, bias, g, w_out):
    a, gate = jnp.split(u, 2, axis=-1)
    u = a * jax.nn.sigmoid(gate)
    y = lax.conv_general_dilated(u, dw[:, None, :], window_strides=(1,),
                                 padding=[(CONV_K // 2, CONV_K // 2)],
                                 dimension_numbers=('NWC', 'WIO', 'NWC'),
                                 feature_group_count=CONV_W) + bias
    return jax.nn.silu(_rms(y, g)) @ w_out


def _rope_tail(x, tables):
    return jnp.concatenate([x[..., :MLA_NOPE], _rope2d(x[..., MLA_NOPE:], tables)], axis=-1)


def _layer(x, cond, P, l, ctx=None, tabs=None):
    b, s, _ = x.shape
    mod = jax.nn.silu(cond) @ P['mod_w'][l] + P['mod_b'][l]
    sh1, sc1, g1, sh2, sc2, g2 = jnp.split(mod[:, None, :], 6, axis=-1)
    h = _rms(x, P['norm1_g'][l]) * (1 + sc1) + sh1
    proj = h @ P['w_in'][l]
    u_conv, dq, dk, dv, cq, ckv, kpe, gl = jnp.split(proj, _split_points(), axis=-1)

    o_conv = _conv_module(u_conv, P['conv_dw'][l], P['conv_b'][l], P['conv_norm_g'][l], P['w_conv_out'][l])

    q = _rms(dq.reshape(b, s, DIFF_HEADS, 2, DIFF_HD), P['diff_q_norm'][l])
    k = _rms(dk.reshape(b, s, DIFF_HEADS, 2, DIFF_HD), P['diff_k_norm'][l])
    v = dv.reshape(b, s, DIFF_HEADS, 2 * DIFF_HD)

    cq = _rms(cq, P['mla_q_a_norm'][l])
    qm = _rms((cq @ P['w_uq'][l]).reshape(b, s, MLA_HEADS, MLA_QK), P['mla_q_norm'][l])
    ckv = _rms(ckv, P['mla_kv_a_norm'][l])
    state = (k.reshape(b, s, DIFF_HEADS, 2 * DIFF_HD), v, ckv, kpe)
    km, vm = _mla_expand(ckv, kpe, P['w_ukv'][l], P['mla_k_norm'][l])

    if ctx is not None:
        ck, cv, cckv, ckpe = ctx
        q = _rope2d(q, tabs[0])
        k = _rope2d(k, tabs[0])
        qm = _rope_tail(qm, tabs[1])
        km = _rope_tail(km, tabs[1])
        lc = ck.shape[1]
        k = jnp.concatenate([ck.reshape(b, lc, DIFF_HEADS, 2, DIFF_HD), k], axis=1)
        v = jnp.concatenate([cv, v], axis=1)
        kmc, vmc = _mla_expand(cckv, ckpe, P['w_ukv'][l], P['mla_k_norm'][l])
        km = jnp.concatenate([kmc, km], axis=1)
        vm = jnp.concatenate([vmc, vm], axis=1)

    lam_init = 0.8 - 0.6 * math.exp(-0.3 * l)
    lp = P['diff_lambda'][l].astype(jnp.float32)
    lam = jnp.exp(jnp.sum(lp[0] * lp[1])) - jnp.exp(jnp.sum(lp[2] * lp[3])) + lam_init
    od = _rms(_diff_attend(q, k, v, lam), P['diff_subln'][l]) * (1 - lam_init)
    o_diff = od.reshape(b, s, DIFF_W) @ P['w_diff_out'][l]
    o_mla = _mla_attend(qm, km, vm).reshape(b, s, MLA_W) @ P['w_mla_out'][l]

    gates = jax.nn.sigmoid(gl).reshape(b, s, N_BRANCH, D_MODEL)
    merged = gates[..., 0, :] * o_conv + gates[..., 1, :] * o_diff + gates[..., 2, :] * o_mla
    x = x + g1 * (merged @ P['w_out'][l])

    h = _rms(x, P['norm2_g'][l]) * (1 + sc2) + sh2
    x = x + g2 * (jnp.square(jax.nn.relu(h @ P['w_up'][l])) @ P['w_down'][l])
    return x, state


def setup_inputs(seed: int = 0) -> dict:
    key = jax.random.key(seed)
    ks = jax.random.split(key, 40)
    f = jnp.float32
    def nrm(i, shape, scale=1.0):
        return jax.random.normal(ks[i], shape, f) * scale
    def gain(i, shape):
        return 1.0 + 0.01 * jax.random.normal(ks[i], shape, f)
    return {
        'x_prompt': nrm(0, (BATCH, SEQ, D_MODEL)),
        'x_sample': nrm(1, (DEC_BATCH, DEC_SEQ, D_MODEL)),
        'cache_diff_k': nrm(2, (DEC_BATCH, DEPTH, PAST_LEN, DIFF_HEADS, 2 * DIFF_HD)),
        'cache_diff_v': nrm(3, (DEC_BATCH, DEPTH, PAST_LEN, DIFF_HEADS, 2 * DIFF_HD)),
        'cache_mla_ckv': nrm(4, (DEC_BATCH, DEPTH, PAST_LEN, MLA_KV_RANK)),
        'cache_mla_kpe': nrm(5, (DEC_BATCH, DEPTH, PAST_LEN, MLA_ROPE)),
        'c': nrm(6, (DEC_BATCH, D_MODEL)),
        'c_ctx': nrm(7, (D_MODEL,)),
        'mod_w': nrm(8, (DEPTH, D_MODEL, 6 * D_MODEL), D_MODEL ** -0.5),
        'mod_b': nrm(9, (DEPTH, 6 * D_MODEL), 0.01),
        'norm1_g': gain(10, (DEPTH, D_MODEL)),
        'w_in': nrm(11, (DEPTH, D_MODEL, IN_COLS), D_MODEL ** -0.5),
        'conv_dw': nrm(12, (DEPTH, CONV_K, CONV_W), CONV_K ** -0.5),
        'conv_b': nrm(13, (DEPTH, CONV_W), 0.01),
        'conv_norm_g': gain(14, (DEPTH, CONV_W)),
        'w_conv_out': nrm(15, (DEPTH, CONV_W, D_MODEL), CONV_W ** -0.5),
        'diff_q_norm': gain(16, (DEPTH, DIFF_HD)),
        'diff_k_norm': gain(17, (DEPTH, DIFF_HD)),
        'diff_lambda': nrm(18, (DEPTH, 4, DIFF_HD), 0.1),
        'diff_subln': gain(19, (DEPTH, 2 * DIFF_HD)),
        'w_diff_out': nrm(20, (DEPTH, DIFF_W, D_MODEL), DIFF_W ** -0.5),
        'mla_q_a_norm': gain(21, (DEPTH, MLA_Q_RANK)),
        'mla_kv_a_norm': gain(22, (DEPTH, MLA_KV_RANK)),
        'w_uq': nrm(23, (DEPTH, MLA_Q_RANK, MLA_HEADS * MLA_QK), MLA_Q_RANK ** -0.5),
        'w_ukv': nrm(24, (DEPTH, MLA_KV_RANK, MLA_HEADS * (MLA_NOPE + MLA_V)), MLA_KV_RANK ** -0.5),
        'mla_q_norm': gain(25, (DEPTH, MLA_QK)),
        'mla_k_norm': gain(26, (DEPTH, MLA_QK)),
        'w_mla_out': nrm(27, (DEPTH, MLA_W, D_MODEL), MLA_W ** -0.5),
        'w_out': nrm(28, (DEPTH, D_MODEL, D_MODEL), D_MODEL ** -0.5),
        'norm2_g': gain(29, (DEPTH, D_MODEL)),
        'w_up': nrm(30, (DEPTH, D_MODEL, D_FF), D_MODEL ** -0.5),
        'w_down': nrm(31, (DEPTH, D_FF, D_MODEL), D_FF ** -0.5),
    }


def reference(x_prompt, x_sample, cache_diff_k, cache_diff_v, cache_mla_ckv, cache_mla_kpe, c, c_ctx,
              mod_w, mod_b, norm1_g, w_in, conv_dw, conv_b, conv_norm_g, w_conv_out,
              diff_q_norm, diff_k_norm, diff_lambda, diff_subln, w_diff_out,
              mla_q_a_norm, mla_kv_a_norm, w_uq, w_ukv, mla_q_norm, mla_k_norm, w_mla_out,
              w_out, norm2_g, w_up, w_down):
    P = dict(mod_w=mod_w, mod_b=mod_b, norm1_g=norm1_g, w_in=w_in, conv_dw=conv_dw, conv_b=conv_b,
             conv_norm_g=conv_norm_g, w_conv_out=w_conv_out, diff_q_norm=diff_q_norm,
             diff_k_norm=diff_k_norm, diff_lambda=diff_lambda, diff_subln=diff_subln,
             w_diff_out=w_diff_out, mla_q_a_norm=mla_q_a_norm, mla_kv_a_norm=mla_kv_a_norm,
             w_uq=w_uq, w_ukv=w_ukv, mla_q_norm=mla_q_norm, mla_k_norm=mla_k_norm,
             w_mla_out=w_mla_out, w_out=w_out, norm2_g=norm2_g, w_up=w_up, w_down=w_down)

    xp = x_prompt
    cond_ctx = c_ctx[None, :]
    st_k, st_v, st_ckv, st_kpe = [], [], [], []
    for l in range(DEPTH):
        xp, (sk, sv, sckv, skpe) = _layer(xp, cond_ctx, P, l)
        st_k.append(sk)
        st_v.append(sv)
        st_ckv.append(sckv)
        st_kpe.append(skpe)
    y_prompt = xp
    new_diff_k = jnp.stack(st_k, axis=1)
    new_diff_v = jnp.stack(st_v, axis=1)
    new_mla_ckv = jnp.stack(st_ckv, axis=1)
    new_mla_kpe = jnp.stack(st_kpe, axis=1)

    n_lat = x_sample.shape[1]
    tabs = (_axial_tables(n_lat, DIFF_HD), _axial_tables(n_lat, MLA_ROPE))
    xs = x_sample
    for l in range(DEPTH):
        ctx = (cache_diff_k[:, l], cache_diff_v[:, l], cache_mla_ckv[:, l], cache_mla_kpe[:, l])
        xs, _ = _layer(xs, c, P, l, ctx=ctx, tabs=tabs)
    y_sample = xs
    return (y_prompt, y_sample, new_diff_k, new_diff_v, new_mla_ckv, new_mla_kpe)
```

```cpp
#include <hip/hip_runtime.h>
#include <cstdio>
#include <cstdint>

#define LAS __attribute__((address_space(3)))
#define GAS __attribute__((address_space(1)))
typedef unsigned short bf16_t;
typedef short bf16x8 __attribute__((ext_vector_type(8)));
typedef short s16x4 __attribute__((ext_vector_type(4)));
typedef float f32x4 __attribute__((ext_vector_type(4)));
typedef float f32x16 __attribute__((ext_vector_type(16)));
typedef unsigned u32x4 __attribute__((ext_vector_type(4)));
typedef unsigned u32x2 __attribute__((ext_vector_type(2)));
typedef float f32x2_t __attribute__((ext_vector_type(2)));
typedef __bf16 bf16x2_t __attribute__((ext_vector_type(2)));
typedef short v4i16_t __attribute__((ext_vector_type(4)));

#ifndef MK_PER_PHASE
#define MK_PER_PHASE 0
#endif

constexpr int DM = 1024, MROWS = 8192, MPROMPT = 4096, KROWS = 8704, NIN = 6304, NINP = 6400, DFF = 4096;
constexpr float EPSF = 1e-6f;
constexpr float LOG2E = 1.4426950408889634f;
constexpr size_t OUT_Y = 0, OUT_DK = 8388608, OUT_DV = 12582912, OUT_CKV = 16777216, OUT_KPE = 18874368;

constexpr size_t al256(size_t x) { return (x + 255) & ~(size_t)255; }
constexpr size_t WS_CTL = 0, CTL_ZERO_BYTES = 65536;
constexpr size_t WS_BT1 = 1u << 20;
constexpr size_t WS_BT2A = WS_BT1 + (size_t)NINP * 1024 * 2;
constexpr size_t WS_BT2B = WS_BT2A + (size_t)768 * 384 * 2;
constexpr size_t WS_BT4 = WS_BT2B + (size_t)1024 * 256 * 2;
constexpr size_t WS_BT5 = WS_BT4 + (size_t)1024 * 1536 * 2;
constexpr size_t WS_BT6 = WS_BT5 + (size_t)1024 * 1024 * 2;
constexpr size_t WS_BT7 = WS_BT6 + (size_t)4096 * 1024 * 2;
constexpr size_t WS_MOD = WS_BT7 + (size_t)1024 * 4096 * 2;
constexpr size_t WS_BIAS1 = WS_MOD + al256(2 * 3 * 6144 * 4);
constexpr size_t WS_BIAS2 = WS_BIAS1 + al256(2 * 3 * NIN * 4);
constexpr size_t WS_TAB = WS_BIAS2 + al256(2 * 3 * 4096 * 4);
constexpr size_t WS_XN = WS_TAB + 16384;
constexpr size_t WS_XSS = WS_XN + (size_t)MROWS * 1024 * 2;
constexpr size_t WS_U = WS_XSS + (size_t)MROWS * 16 * 4;
constexpr size_t WS_QD = WS_U + (size_t)MROWS * 512 * 2;
constexpr size_t WS_KD = WS_QD + (size_t)MROWS * 512 * 2;
constexpr size_t WS_VD = WS_KD + (size_t)KROWS * 512 * 2;
constexpr size_t WS_CQ = WS_VD + (size_t)KROWS * 512 * 2;
constexpr size_t WS_CQP = WS_CQ + (size_t)MROWS * 384 * 2;
constexpr size_t WS_CKVA = WS_CQP + (size_t)MROWS * 8 * 4;
constexpr size_t WS_CKVP = WS_CKVA + (size_t)KROWS * 256 * 2;
constexpr size_t WS_KPER = WS_CKVP + (size_t)MROWS * 4 * 4;
constexpr size_t WS_KPESS = WS_KPER + (size_t)KROWS * 32 * 4;
constexpr size_t WS_QM = WS_KPESS + al256(KROWS * 4);
constexpr size_t WS_QSS = WS_QM + (size_t)MROWS * 768 * 2;
constexpr size_t WS_KM = WS_QSS + (size_t)MROWS * 24 * 4;
constexpr size_t WS_VM = WS_KM + (size_t)KROWS * 768 * 2;
constexpr size_t WS_ACAT = WS_VM + (size_t)KROWS * 512 * 2;
constexpr size_t WS_MG = WS_ACAT + (size_t)MROWS * 1536 * 2;
constexpr size_t WS_R1 = WS_MG + (size_t)MROWS * 1024 * 2;
constexpr size_t WS_END = WS_R1 + (size_t)MROWS * 4096 * 2;
static_assert(WS_END <= 268435456, "d_ws map exceeds 256 MiB");

constexpr int RING_BYTES = 131072, LDSCTL_OFF = RING_BYTES, LDS_BYTES = 147456;

__device__ __forceinline__ unsigned pk2(float lo, float hi) { f32x2_t v = {lo, hi}; bf16x2_t b = __builtin_convertvector(v, bf16x2_t); return __builtin_bit_cast(unsigned, b); }
__device__ __forceinline__ float bflo(unsigned w) { return __uint_as_float(w << 16); }
__device__ __forceinline__ float bfhi(unsigned w) { return __uint_as_float(w & 0xffff0000u); }
__device__ __forceinline__ float sigmoidf_(float x) { return __builtin_amdgcn_rcpf(1.0f + __expf(-x)); }
__device__ __forceinline__ float wave_sum(float v) {
#pragma unroll
    for (int o = 1; o < 64; o <<= 1) v += __shfl_xor(v, o);
    return v;
}
__device__ __forceinline__ float sum4(f32x4 a) { return (a[0] + a[1]) + (a[2] + a[3]); }
__device__ __forceinline__ float rinv16(const float* p, float invn) {
    const f32x4 a = ((const f32x4*)p)[0], b = ((const f32x4*)p)[1], c = ((const f32x4*)p)[2], d = ((const f32x4*)p)[3];
    return rsqrtf(((sum4(a) + sum4(b)) + (sum4(c) + sum4(d))) * invn + EPSF);
}
__device__ __forceinline__ int keyrow(int row) {
    return row < 4096 ? row : (row < 8192 ? row + 256 * (((row - 4096) >> 11) + 1) : 4096 + ((row - 8192) >> 8) * 2304 + ((row - 8192) & 255));
}
__device__ __forceinline__ int crow(int r, int hi) { return (r & 3) + 8 * (r >> 2) + 4 * hi; }
#define LDS_WAIT() asm volatile("s_waitcnt lgkmcnt(0)" ::: "memory")
#define MEMFENCE() asm volatile("" ::: "memory")
template <class T> __device__ __forceinline__ T* launder(T* p) { asm volatile("" : "+s"(p)); return p; }
__device__ __forceinline__ int mk_tid(int wave0) {
    int tid = wave0 * 64 + (int)__builtin_amdgcn_mbcnt_hi(~0u, __builtin_amdgcn_mbcnt_lo(~0u, 0u));
    asm volatile("" : "+v"(tid));
    return tid;
}
#define VM_WAIT() asm volatile("s_waitcnt vmcnt(0)" ::: "memory")

namespace pg8 {
constexpr int BM = 256, BK = 64, HALF = 128, HTB = HALF * BK * 2, STAGE_BYTES = 8 * HTB, NXCD = 8, WGM = 8;
__host__ __device__ __forceinline__ int lds_byte(int r, int c) { const int st = (r >> 4) * 2 + (c >> 5), rr = r & 15, cc = c & 31, ob = rr * 64 + cc * 2; return st * 1024 + (ob ^ (((ob >> 9) & 1) << 5)); }
__host__ __device__ __forceinline__ void stage_rc(int b, int& R, int& C) { const int st = b / 1024, sb = b % 1024, swz = sb ^ (((sb >> 9) & 1) << 5); R = (st >> 1) * 16 + swz / 64; C = (st & 1) * 32 + (swz % 64) / 2; }
struct Unit { int pm, pn; };
struct Gemm { const bf16_t* A; const bf16_t* Bt; int M, N, K; };
struct StaticOrder {
    int nM, nN, nwg, G, c;
    __host__ __device__ void init(int M, int N, int G_, int c_) { nM = M / BM; nN = N / BM; nwg = nM * nN; G = G_; c = c_; }
    __host__ __device__ bool next(int i, Unit& u) const {
        const long L = (long)i * G + c; if (L >= nwg) return false;
        int wgid = (int)L; { const int q = nwg / NXCD, r = nwg % NXCD, xcd = wgid % NXCD, off = wgid / NXCD; wgid = (xcd < r ? xcd * (q + 1) : r * (q + 1) + (xcd - r) * q) + off; }
        const int nig = WGM * nN, gid = wgid / nig, fm = gid * WGM, gsz = (nM - fm) < WGM ? (nM - fm) : WGM;
        u.pm = fm + ((wgid % nig) % gsz); u.pn = (wgid % nig) / gsz; return true;
    }
};
template <class Epi, bool ALIGN_EPI>
__device__ __forceinline__ void gemm_phase(LAS unsigned char* lds, const Gemm g, const StaticOrder& S, const Epi& E, int wave0) {
    const int tid = mk_tid(wave0);
    const int wid = __builtin_amdgcn_readfirstlane(tid >> 6), lane = tid & 63, wr = wid >> 2, wc = wid & 3, fr = lane & 15, fq = lane >> 4;
    const int K = g.K, nt = K / BK;
    unsigned voffA[2];
#pragma unroll
    for (int i = 0; i < 2; ++i) { int R, C; stage_rc(tid * 16 + i * 8192, R, C); voffA[i] = (unsigned)(R * K + C) * 2u; }
    const size_t kstep = (size_t)(BK * 2);
    const size_t hstep = (size_t)HALF * K * 2;
    const size_t tstep = 2 * hstep;
    const unsigned ldsw = (unsigned)wid * 1024u;
    const int aoff = lds_byte(wr * 64 + fr, fq * 8), boff = lds_byte(wc * 32 + fr, fq * 8);
#define PG8_SA(b, h) (((b) * 2 + (h)) * HTB)
#define PG8_SB(b, h) ((4 + (b) * 2 + (h)) * HTB)
#define PG8_STAGE(bufoff, gbase) do { _Pragma("unroll") for (int _i = 0; _i < 2; ++_i) \
        __builtin_amdgcn_global_load_lds((const unsigned*)((const char*)(gbase) + voffA[_i]), (LAS unsigned*)(lds + (bufoff) + ldsw + _i * 8192), 16, 0, 0); } while (0)
#define PG8_LDA(dst, b, h) do { _Pragma("unroll") for (int m = 0; m < 4; ++m) _Pragma("unroll") for (int k = 0; k < 2; ++k) dst[m][k] = *(const LAS bf16x8*)(lds + PG8_SA(b, h) + aoff + m * 2048 + k * 1024); } while (0)
#define PG8_LDB(dst, b, h) do { _Pragma("unroll") for (int n = 0; n < 2; ++n) _Pragma("unroll") for (int k = 0; k < 2; ++k) dst[n][k] = *(const LAS bf16x8*)(lds + PG8_SB(b, h) + boff + n * 2048 + k * 1024); } while (0)
#define PG8_MMA(ai, bj, At, Bt) do { __builtin_amdgcn_s_setprio(1); _Pragma("unroll") for (int m = 0; m < 4; ++m) _Pragma("unroll") for (int n = 0; n < 2; ++n) _Pragma("unroll") for (int k = 0; k < 2; ++k) \
        acc[ai][bj][m][n] = __builtin_amdgcn_mfma_f32_16x16x32_bf16(Bt[n][k], At[m][k], acc[ai][bj][m][n], 0, 0, 0); __builtin_amdgcn_s_setprio(0); } while (0)
#define PG8_WAIT_V(n) asm volatile("s_waitcnt vmcnt(" #n ")" ::: "memory")
#define PG8_WAIT_L(n) asm volatile("s_waitcnt lgkmcnt(" #n ")" ::: "memory")
#define PG8_BAR __builtin_amdgcn_s_barrier()
#define PG8_SCHED __builtin_amdgcn_sched_barrier(0)
    Unit cur, nxt; int ui = 0;
    if (!S.next(0, cur)) return;
    f32x4 acc[2][2][4][2];
#pragma unroll
    for (int a = 0; a < 2; ++a)
#pragma unroll
        for (int b = 0; b < 2; ++b)
#pragma unroll
            for (int m = 0; m < 4; ++m)
#pragma unroll
                for (int n = 0; n < 2; ++n) acc[a][b][m][n] = (f32x4){0.f, 0.f, 0.f, 0.f};
    bf16x8 At[4][2], B0[2][2], B1[2][2];
    const char* cA = (const char*)g.A + (size_t)cur.pm * tstep; const char* cB = (const char*)g.Bt + (size_t)cur.pn * tstep;
    PG8_STAGE(PG8_SB(0, 0), cB); PG8_STAGE(PG8_SB(0, 1), cB + hstep); PG8_STAGE(PG8_SA(0, 0), cA); PG8_STAGE(PG8_SA(0, 1), cA + hstep);
    if (wr == 1) PG8_BAR;
    PG8_WAIT_V(2); PG8_BAR;
    PG8_STAGE(PG8_SB(1, 0), cB + kstep); PG8_STAGE(PG8_SA(1, 0), cA + kstep); PG8_STAGE(PG8_SB(1, 1), cB + hstep + kstep);
    PG8_WAIT_V(6); PG8_BAR;
    for (;;) {
        const bool has_next = S.next(ui + 1, nxt);
        const char* nA = has_next ? (const char*)g.A + (size_t)nxt.pm * tstep : cA; const char* nB = has_next ? (const char*)g.Bt + (size_t)nxt.pn * tstep : cB;
#pragma unroll 1
        for (int t = 0; t < nt; t += 2) {
            if constexpr (Epi::HOOK) { if (t == 8 || t == 16) E.hook(acc, cur, t, wr, wc, fr, fq); }
            const bool last = (t == nt - 2);
            const char* a1 = cA + (size_t)(t + 1) * kstep;
            const char* a2 = last ? nA : cA + (size_t)(t + 2) * kstep; const char* b2 = last ? nB : cB + (size_t)(t + 2) * kstep;
            const char* a3 = a2 + kstep; const char* b3 = b2 + kstep;
            PG8_LDB(B0, 0, 0); PG8_LDB(B1, 0, 1); PG8_SCHED; PG8_LDA(At, 0, 0); PG8_STAGE(PG8_SA(1, 1), a1 + hstep);
            PG8_WAIT_V(8); PG8_WAIT_L(0); PG8_BAR; PG8_MMA(0, 0, At, B0); PG8_MMA(0, 1, At, B1); PG8_BAR; PG8_SCHED;
            PG8_LDA(At, 0, 1); PG8_STAGE(PG8_SB(0, 0), b2); PG8_STAGE(PG8_SB(0, 1), b2 + hstep); PG8_STAGE(PG8_SA(0, 0), a2);
            PG8_WAIT_V(8); PG8_WAIT_L(0); PG8_BAR; PG8_MMA(1, 0, At, B0); PG8_MMA(1, 1, At, B1); PG8_BAR; PG8_SCHED;
            PG8_LDB(B0, 1, 0); PG8_LDB(B1, 1, 1); PG8_SCHED; PG8_LDA(At, 1, 0); PG8_STAGE(PG8_SA(0, 1), a2 + hstep);
            PG8_WAIT_V(8); PG8_WAIT_L(0); PG8_BAR; PG8_MMA(0, 0, At, B0); PG8_MMA(0, 1, At, B1); PG8_BAR; PG8_SCHED;
            PG8_LDA(At, 1, 1); PG8_STAGE(PG8_SB(1, 0), b3); PG8_STAGE(PG8_SB(1, 1), b3 + hstep); PG8_STAGE(PG8_SA(1, 0), a3);
            PG8_WAIT_V(8); PG8_WAIT_L(0); PG8_BAR; PG8_MMA(1, 0, At, B0); PG8_MMA(1, 1, At, B1); PG8_BAR; PG8_SCHED;
        }
        if constexpr (ALIGN_EPI) { if (wr == 0) PG8_BAR; }
        E(acc, cur, wr, wc, fr, fq);
        if (!has_next) break;
#pragma unroll
        for (int a = 0; a < 2; ++a)
#pragma unroll
            for (int b = 0; b < 2; ++b)
#pragma unroll
                for (int m = 0; m < 4; ++m)
#pragma unroll
                    for (int n = 0; n < 2; ++n) acc[a][b][m][n] = (f32x4){0.f, 0.f, 0.f, 0.f};
        cur = nxt; cA = nA; cB = nB; ++ui;
        if constexpr (ALIGN_EPI) { if (wr == 1) PG8_BAR; }
    }
    PG8_WAIT_V(0);
    if constexpr (!ALIGN_EPI) { if (wr == 0) PG8_BAR; }
    PG8_BAR;
#undef PG8_SA
#undef PG8_SB
#undef PG8_STAGE
#undef PG8_LDA
#undef PG8_LDB
#undef PG8_MMA
#undef PG8_WAIT_V
#undef PG8_WAIT_L
#undef PG8_BAR
#undef PG8_SCHED
}
}
using pg8::Unit;
typedef f32x4 Acc[2][2][4][2];


struct EpiIn {
    static constexpr bool HOOK = false;
    unsigned char* ws0; float* out0; const float* gq; const float* gk; int layer;
    __device__ __forceinline__ void hook(Acc&, const Unit&, int, int, int, int, int) const {}
    __device__ __forceinline__ void operator()(const Acc& acc, const Unit& u, int wr, int wc, int fr, int fq) const {
        unsigned char* ws = launder(ws0); float* out = launder(out0);
        const float* xss = (const float*)(ws + WS_XSS); const float* bias = (const float*)(ws + WS_BIAS1) + (size_t)layer * 3 * NIN;
        const float* cosD = (const float*)(ws + WS_TAB); const float* sinD = cosD + 1024;
        bf16_t* U = (bf16_t*)(ws + WS_U); bf16_t* QD = (bf16_t*)(ws + WS_QD); bf16_t* KD = (bf16_t*)(ws + WS_KD); bf16_t* VD = (bf16_t*)(ws + WS_VD);
        bf16_t* CQ = (bf16_t*)(ws + WS_CQ); bf16_t* CKVA = (bf16_t*)(ws + WS_CKVA); bf16_t* G = (bf16_t*)(ws + WS_R1);
        float* cqpart = (float*)(ws + WS_CQP); float* ckvpart = (float*)(ws + WS_CKVP); float* kperaw = (float*)(ws + WS_KPER); float* kpess = (float*)(ws + WS_KPESS);
        const int pm = u.pm, pn = u.pn;
        const int cond = pm < 16 ? 0 : 1 + ((pm - 16) >> 3);
        const bool sample = pm >= 16;
        const int rbase = pm * 256 + wr * 64 + fr;
        const float* bs = bias + cond * NIN;
        if (pn < 4) {
            const int ch0 = 128 * pn + 32 * wc + 8 * fq;
            f32x4 ba[2], bg[2];
#pragma unroll
            for (int n = 0; n < 2; ++n) { ba[n] = *(const f32x4*)(bs + ch0 + 4 * n); bg[n] = *(const f32x4*)(bs + 512 + ch0 + 4 * n); }
#pragma unroll
            for (int ai = 0; ai < 2; ++ai)
#pragma unroll
                for (int m = 0; m < 4; ++m) {
                    const int row = rbase + ai * 128 + m * 16; const float ri = rinv16(xss + (size_t)row * 16, 1.0f / 1024.0f);
                    float o[8];
#pragma unroll
                    for (int n = 0; n < 2; ++n)
#pragma unroll
                        for (int i = 0; i < 4; ++i) { const float a = ri * acc[ai][0][m][n][i] + ba[n][i], gte = ri * acc[ai][1][m][n][i] + bg[n][i]; o[4 * n + i] = a * sigmoidf_(gte); }
                    u32x4 w; w.x = pk2(o[0], o[1]); w.y = pk2(o[2], o[3]); w.z = pk2(o[4], o[5]); w.w = pk2(o[6], o[7]);
                    *(u32x4*)(U + (size_t)row * 512 + ch0) = w;
                    MEMFENCE();
                }
        } else if (pn < 8) {
            const bool isk = pn >= 6; const int grp = 4 * ((pn - 4) & 1) + wc;
            const int ob = (isk ? 1536 : 1024) + 64 * grp; const float* gv = isk ? gk : gq;
            f32x4 bq[2][2], gn[2][2];
#pragma unroll
            for (int bj = 0; bj < 2; ++bj)
#pragma unroll
                for (int n = 0; n < 2; ++n) { bq[bj][n] = *(const f32x4*)(bs + ob + 32 * bj + 16 * n + 4 * fq); gn[bj][n] = *(const f32x4*)(gv + 32 * bj + 16 * n + 4 * fq); }
#pragma unroll
            for (int ai = 0; ai < 2; ++ai)
#pragma unroll
                for (int m = 0; m < 4; ++m) {
                    const int row = rbase + ai * 128 + m * 16; const float ri = rinv16(xss + (size_t)row * 16, 1.0f / 1024.0f);
                    f32x4 v[2][2]; float ss = 0.f;
#pragma unroll
                    for (int bj = 0; bj < 2; ++bj)
#pragma unroll
                        for (int n = 0; n < 2; ++n) { v[bj][n] = acc[ai][bj][m][n] * ri + bq[bj][n]; const f32x4 q2 = v[bj][n] * v[bj][n]; ss += sum4(q2); }
                    ss += __shfl_xor(ss, 16); ss += __shfl_xor(ss, 32);
                    const float rn = rsqrtf(ss * (1.0f / 64.0f) + EPSF);
#pragma unroll
                    for (int bj = 0; bj < 2; ++bj)
#pragma unroll
                        for (int n = 0; n < 2; ++n) v[bj][n] = v[bj][n] * rn * gn[bj][n];
                    if (isk && !sample) {
                        float* op = out + OUT_DK + ((size_t)(pm * 2 + layer) * 256 + (row & 255)) * 512 + 64 * grp + 4 * fq;
#pragma unroll
                        for (int bj = 0; bj < 2; ++bj)
#pragma unroll
                            for (int n = 0; n < 2; ++n) *(f32x4*)(op + 32 * bj + 16 * n) = v[bj][n];
                    }
                    if (sample) {
                        const int s = row & 2047;
#pragma unroll
                        for (int bj = 0; bj < 2; ++bj) {
                            const int pos = bj == 0 ? (s >> 6) : (s & 63);
                            const f32x4 c4 = *(const f32x4*)(cosD + pos * 16 + 4 * fq), s4 = *(const f32x4*)(sinD + pos * 16 + 4 * fq);
                            const f32x4 x1 = v[bj][0], x2 = v[bj][1];
                            v[bj][0] = x1 * c4 - x2 * s4; v[bj][1] = x2 * c4 + x1 * s4;
                        }
                    }
                    const float qs = isk ? 1.0f : 0.125f * LOG2E;
                    bf16_t* dp = (isk ? KD + (size_t)keyrow(row) * 512 : QD + (size_t)row * 512) + 64 * grp + 4 * fq;
#pragma unroll
                    for (int bj = 0; bj < 2; ++bj)
#pragma unroll
                        for (int n = 0; n < 2; ++n) { const f32x4 x = v[bj][n] * qs; u32x2 w; w.x = pk2(x[0], x[1]); w.y = pk2(x[2], x[3]); *(u32x2*)(dp + 32 * bj + 16 * n) = w; }
                    MEMFENCE();
                }
        } else {
            int obase, kind;
            if (pn < 10) { kind = 0; obase = 2048 + 256 * (pn - 8); }
            else if (pn == 10) { kind = 1; obase = 2560; }
            else if (pn == 11) { kind = 2; obase = 2816; }
            else if (pn == 12) { kind = 3; obase = 2944; }
            else { kind = 4; obase = 3232 + 256 * (pn - 13); }
            const int lc0 = 32 * wc + 8 * fq;
#pragma unroll
            for (int ai = 0; ai < 2; ++ai)
#pragma unroll
                for (int m = 0; m < 4; ++m) {
                    const int row = rbase + ai * 128 + m * 16; const float ri = rinv16(xss + (size_t)row * 16, 1.0f / 1024.0f);
                    float ssw = 0.f;
#pragma unroll
                    for (int bj = 0; bj < 2; ++bj) {
                        int oc = obase + 128 * bj + lc0;
                        bool live = true;
                        if (kind == 2 && bj == 1) { oc = 3200 + 8 * fq; live = (wc == 0); }
                        float o[8];
                        if (live) {
                            const f32x4 b0 = *(const f32x4*)(bs + oc), b1 = *(const f32x4*)(bs + oc + 4);
#pragma unroll
                            for (int i = 0; i < 4; ++i) { o[i] = ri * acc[ai][bj][m][0][i] + b0[i]; o[4 + i] = ri * acc[ai][bj][m][1][i] + b1[i]; }
                        } else {
#pragma unroll
                            for (int i = 0; i < 8; ++i) o[i] = 0.f;
                        }
                        float ssl = 0.f;
#pragma unroll
                        for (int i = 0; i < 8; ++i) ssl += o[i] * o[i];
                        const int lc = 128 * bj + lc0;
                        if (kind == 0) {
                            const int col = 256 * (pn - 8) + lc;
                            u32x4 w; w.x = pk2(o[0], o[1]); w.y = pk2(o[2], o[3]); w.z = pk2(o[4], o[5]); w.w = pk2(o[6], o[7]);
                            *(u32x4*)(VD + (size_t)keyrow(row) * 512 + col) = w;
                            if (!sample) { float* op = out + OUT_DV + ((size_t)(pm * 2 + layer) * 256 + (row & 255)) * 512 + col;
                                *(f32x4*)op = (f32x4){o[0], o[1], o[2], o[3]}; *(f32x4*)(op + 4) = (f32x4){o[4], o[5], o[6], o[7]}; }
                        } else if (kind == 1 || (kind == 2 && bj == 0)) {
                            const int col = (kind == 1 ? 0 : 256) + lc;
                            u32x4 w; w.x = pk2(o[0], o[1]); w.y = pk2(o[2], o[3]); w.z = pk2(o[4], o[5]); w.w = pk2(o[6], o[7]);
                            *(u32x4*)(CQ + (size_t)row * 384 + col) = w; ssw += ssl;
                        } else if (kind == 2) {
                            float st = ssl; st += __shfl_xor(st, 16); st += __shfl_xor(st, 32);
                            if (live) {
                                float* kp = kperaw + (size_t)row * 32 + 8 * fq;
                                *(f32x4*)kp = (f32x4){o[0], o[1], o[2], o[3]}; *(f32x4*)(kp + 4) = (f32x4){o[4], o[5], o[6], o[7]};
                                if (fq == 0) kpess[row] = st;
                                if (!sample) { float* op = out + OUT_KPE + ((size_t)(pm * 2 + layer) * 256 + (row & 255)) * 32 + 8 * fq;
                                    *(f32x4*)op = (f32x4){o[0], o[1], o[2], o[3]}; *(f32x4*)(op + 4) = (f32x4){o[4], o[5], o[6], o[7]}; }
                            }
                        } else if (kind == 3) {
                            u32x4 w; w.x = pk2(o[0], o[1]); w.y = pk2(o[2], o[3]); w.z = pk2(o[4], o[5]); w.w = pk2(o[6], o[7]);
                            *(u32x4*)(CKVA + (size_t)row * 256 + lc) = w; ssw += ssl;
                            if (!sample) { float* op = out + OUT_CKV + ((size_t)(pm * 2 + layer) * 256 + (row & 255)) * 256 + lc;
                                *(f32x4*)op = (f32x4){o[0], o[1], o[2], o[3]}; *(f32x4*)(op + 4) = (f32x4){o[4], o[5], o[6], o[7]}; }
                        } else {
                            const int col = 256 * (pn - 13) + lc;
                            u32x4 w; w.x = pk2(sigmoidf_(o[0]), sigmoidf_(o[1])); w.y = pk2(sigmoidf_(o[2]), sigmoidf_(o[3])); w.z = pk2(sigmoidf_(o[4]), sigmoidf_(o[5])); w.w = pk2(sigmoidf_(o[6]), sigmoidf_(o[7]));
                            *(u32x4*)(G + (size_t)row * 3072 + col) = w;
                        }
                    }
                    if (kind == 1 || kind == 2 || kind == 3) {
                        ssw += __shfl_xor(ssw, 16); ssw += __shfl_xor(ssw, 32);
                        if (fq == 0) { if (kind == 1) cqpart[(size_t)row * 8 + wc] = ssw; else if (kind == 2) cqpart[(size_t)row * 8 + 4 + wc] = ssw; else ckvpart[(size_t)row * 4 + wc] = ssw; }
                    }
                    MEMFENCE();
                }
        }
    }
};

struct EpiQM {
    static constexpr bool HOOK = false;
    unsigned char* ws0; const float* gqm;
    __device__ __forceinline__ void hook(Acc&, const Unit&, int, int, int, int, int) const {}
    __device__ __forceinline__ void operator()(const Acc& acc, const Unit& u, int wr, int wc, int fr, int fq) const {
        unsigned char* ws = launder(ws0);
        const float* cosM = (const float*)(ws + WS_TAB) + 2048; const float* sinM = cosM + 512; bf16_t* QM = (bf16_t*)(ws + WS_QM); float* qss = (float*)(ws + WS_QSS);
        const int pm = u.pm, pn = u.pn; const bool sample = pm >= 16; const int rbase = pm * 256 + wr * 64 + fr;
#pragma unroll
        for (int bj = 0; bj < 2; ++bj) {
            const int blk = 8 * pn + 4 * bj + wc, h = blk / 3, part = blk - 3 * h;
            int d0, d1;
            if (part < 2) { d0 = 32 * part + 4 * fq; d1 = d0 + 16; } else { d0 = 64 + 16 * (fq >> 1) + 4 * (fq & 1); d1 = d0 + 8; }
            const f32x4 g0 = *(const f32x4*)(gqm + d0), g1 = *(const f32x4*)(gqm + d1);
#pragma unroll
            for (int ai = 0; ai < 2; ++ai)
#pragma unroll
                for (int m = 0; m < 4; ++m) {
                    const int row = rbase + ai * 128 + m * 16;
                    const f32x4 z0 = acc[ai][bj][m][0], z1 = acc[ai][bj][m][1];
                    float ss = sum4(z0 * z0) + sum4(z1 * z1); ss += __shfl_xor(ss, 16); ss += __shfl_xor(ss, 32);
                    if (fq == 0) qss[(size_t)row * 24 + blk] = ss;
                    f32x4 y0 = z0 * g0, y1 = z1 * g1;
                    if (part == 2 && sample) {
                        const int s = row & 2047, pos = (fq >> 1) == 0 ? (s >> 6) : (s & 63);
                        const f32x4 c4 = *(const f32x4*)(cosM + pos * 8 + 4 * (fq & 1)), s4 = *(const f32x4*)(sinM + pos * 8 + 4 * (fq & 1));
                        const f32x4 x1 = y0, x2 = y1; y0 = x1 * c4 - x2 * s4; y1 = x2 * c4 + x1 * s4;
                    }
                    bf16_t* dp = QM + (size_t)row * 768 + 96 * h;
                    u32x2 w0, w1; w0.x = pk2(y0[0], y0[1]); w0.y = pk2(y0[2], y0[3]); w1.x = pk2(y1[0], y1[1]); w1.y = pk2(y1[2], y1[3]);
                    *(u32x2*)(dp + d0) = w0; *(u32x2*)(dp + d1) = w1;
                    MEMFENCE();
                }
        }
    }
};

struct EpiKV {
    static constexpr bool HOOK = false;
    unsigned char* ws0; float* out0; const float* gkm; const float* gkva; int layer;
    __device__ __forceinline__ void hook(Acc&, const Unit&, int, int, int, int, int) const {}
    __device__ __forceinline__ void operator()(const Acc& acc, const Unit& u, int wr, int wc, int fr, int fq) const {
        unsigned char* ws = launder(ws0); float* out = launder(out0);
        const float* ckvpart = (const float*)(ws + WS_CKVP); const float* kpess = (const float*)(ws + WS_KPESS); const float* kperaw = (const float*)(ws + WS_KPER);
        const float* cosM = (const float*)(ws + WS_TAB) + 2048; const float* sinM = cosM + 512; bf16_t* KM = (bf16_t*)(ws + WS_KM); bf16_t* VM = (bf16_t*)(ws + WS_VM);
        const int pm = u.pm, pn = u.pn; const int rbase = pm * 256 + wr * 64 + fr;
        const bool newtok = pm < 32, rope = pm >= 16 && pm < 32;
#pragma unroll
        for (int ai = 0; ai < 2; ++ai)
#pragma unroll
            for (int m = 0; m < 4; ++m) {
                const int row = rbase + ai * 128 + m * 16; const int kr = keyrow(row);
                float rc = 1.0f;
                if (newtok) { const f32x4 p = *(const f32x4*)(ckvpart + (size_t)row * 4); rc = rsqrtf(sum4(p) * (1.0f / 256.0f) + EPSF); }
                if (pn < 2) {
                    const int h = 4 * pn + wc;
                    f32x4 v[2][2]; float ss = 0.f;
#pragma unroll
                    for (int bj = 0; bj < 2; ++bj)
#pragma unroll
                        for (int n = 0; n < 2; ++n) { v[bj][n] = acc[ai][bj][m][n] * rc; ss += sum4(v[bj][n] * v[bj][n]); }
                    ss += __shfl_xor(ss, 16); ss += __shfl_xor(ss, 32);
                    ss += kpess[row];
                    const float rk = rsqrtf(ss * (1.0f / 96.0f) + EPSF);
                    bf16_t* dp = KM + (size_t)kr * 768 + 96 * h;
#pragma unroll
                    for (int bj = 0; bj < 2; ++bj)
#pragma unroll
                        for (int n = 0; n < 2; ++n) { const int d = 32 * bj + 16 * n + 4 * fq; const f32x4 x = v[bj][n] * rk * *(const f32x4*)(gkm + d);
                            u32x2 w; w.x = pk2(x[0], x[1]); w.y = pk2(x[2], x[3]); *(u32x2*)(dp + d) = w; }
                    const int e0 = 16 * (fq >> 1) + 4 * (fq & 1);
                    f32x4 x1 = *(const f32x4*)(kperaw + (size_t)row * 32 + e0) * rk * *(const f32x4*)(gkm + 64 + e0);
                    f32x4 x2 = *(const f32x4*)(kperaw + (size_t)row * 32 + e0 + 8) * rk * *(const f32x4*)(gkm + 64 + e0 + 8);
                    if (rope) {
                        const int s = row & 2047, pos = (fq >> 1) == 0 ? (s >> 6) : (s & 63);
                        const f32x4 c4 = *(const f32x4*)(cosM + pos * 8 + 4 * (fq & 1)), s4 = *(const f32x4*)(sinM + pos * 8 + 4 * (fq & 1));
                        const f32x4 a = x1, b = x2; x1 = a * c4 - b * s4; x2 = b * c4 + a * s4;
                    }
                    u32x2 w0, w1; w0.x = pk2(x1[0], x1[1]); w0.y = pk2(x1[2], x1[3]); w1.x = pk2(x2[0], x2[1]); w1.y = pk2(x2[2], x2[3]);
                    *(u32x2*)(dp + 64 + e0) = w0; *(u32x2*)(dp + 64 + e0 + 8) = w1;
                } else {
#pragma unroll
                    for (int bj = 0; bj < 2; ++bj) {
                        const int lc = 256 * (pn - 2) + 128 * bj + 32 * wc + 8 * fq;
                        const f32x4 a = acc[ai][bj][m][0] * rc, b = acc[ai][bj][m][1] * rc;
                        u32x4 w; w.x = pk2(a[0], a[1]); w.y = pk2(a[2], a[3]); w.z = pk2(b[0], b[1]); w.w = pk2(b[2], b[3]);
                        *(u32x4*)(VM + (size_t)kr * 512 + lc) = w;
                    }
                    if (pn == 2 && pm < 16) {
                        float* op = out + OUT_CKV + ((size_t)(pm * 2 + layer) * 256 + (row & 255)) * 256 + 64 * wc + 4 * fq;
#pragma unroll
                        for (int t = 0; t < 4; ++t) { f32x4 x = *(f32x4*)(op + 16 * t); x = x * rc * *(const f32x4*)(gkva + 64 * wc + 4 * fq + 16 * t); *(f32x4*)(op + 16 * t) = x; }
                    }
                }
                MEMFENCE();
            }
    }
};

struct EpiMerge {
    static constexpr bool HOOK = true;
    unsigned char* ws0;
    __device__ __forceinline__ void hook(Acc& acc, const Unit& u, int t, int wr, int wc, int fr, int fq) const {
        unsigned char* ws = launder(ws0); const bf16_t* G = (const bf16_t*)(ws + WS_R1);
        const int seg = (t == 8) ? 0 : 1; int rbase = u.pm * 256 + wr * 64 + fr; asm volatile("" : "+v"(rbase));
#pragma unroll
        for (int ai = 0; ai < 2; ++ai)
#pragma unroll
            for (int m = 0; m < 4; ++m) {
                const int row = rbase + ai * 128 + m * 16;
#pragma unroll
                for (int bj = 0; bj < 2; ++bj) {
                    const int col = 256 * u.pn + 128 * bj + 32 * wc + 8 * fq;
                    const u32x4 ga = *(const u32x4*)(G + (size_t)row * 3072 + seg * 1024 + col), gb = *(const u32x4*)(G + (size_t)row * 3072 + (seg + 1) * 1024 + col);
                    acc[ai][bj][m][0][0] *= bflo(ga.x) * __builtin_amdgcn_rcpf(bflo(gb.x)); acc[ai][bj][m][0][1] *= bfhi(ga.x) * __builtin_amdgcn_rcpf(bfhi(gb.x));
                    acc[ai][bj][m][0][2] *= bflo(ga.y) * __builtin_amdgcn_rcpf(bflo(gb.y)); acc[ai][bj][m][0][3] *= bfhi(ga.y) * __builtin_amdgcn_rcpf(bfhi(gb.y));
                    acc[ai][bj][m][1][0] *= bflo(ga.z) * __builtin_amdgcn_rcpf(bflo(gb.z)); acc[ai][bj][m][1][1] *= bfhi(ga.z) * __builtin_amdgcn_rcpf(bfhi(gb.z));
                    acc[ai][bj][m][1][2] *= bflo(ga.w) * __builtin_amdgcn_rcpf(bflo(gb.w)); acc[ai][bj][m][1][3] *= bfhi(ga.w) * __builtin_amdgcn_rcpf(bfhi(gb.w));
                    MEMFENCE();
                }
            }
    }
    __device__ __forceinline__ void operator()(const Acc& acc, const Unit& u, int wr, int wc, int fr, int fq) const {
        unsigned char* ws = launder(ws0); const bf16_t* G = (const bf16_t*)(ws + WS_R1); bf16_t* MG = (bf16_t*)(ws + WS_MG);
        const int rbase = u.pm * 256 + wr * 64 + fr;
#pragma unroll
        for (int ai = 0; ai < 2; ++ai)
#pragma unroll
            for (int m = 0; m < 4; ++m) {
                const int row = rbase + ai * 128 + m * 16;
#pragma unroll
                for (int bj = 0; bj < 2; ++bj) {
                    const int col = 256 * u.pn + 128 * bj + 32 * wc + 8 * fq;
                    const u32x4 g = *(const u32x4*)(G + (size_t)row * 3072 + 2048 + col);
                    const f32x4 a = acc[ai][bj][m][0], b = acc[ai][bj][m][1];
                    u32x4 w; w.x = pk2(a[0] * bflo(g.x), a[1] * bfhi(g.x)); w.y = pk2(a[2] * bflo(g.y), a[3] * bfhi(g.y));
                    w.z = pk2(b[0] * bflo(g.z), b[1] * bfhi(g.z)); w.w = pk2(b[2] * bflo(g.w), b[3] * bfhi(g.w));
                    *(u32x4*)(MG + (size_t)row * 1024 + col) = w;
                }
                MEMFENCE();
            }
    }
};

struct EpiRes {
    static constexpr bool HOOK = false;
    const float* base_p; const float* base_s;
    float* out0;
    unsigned char* ws0; int gate_off;
    const float* cs_g; int cs_off;
    __device__ __forceinline__ void hook(Acc&, const Unit&, int, int, int, int, int) const {}
    __device__ __forceinline__ void operator()(const Acc& acc, const Unit& u, int wr, int wc, int fr, int fq) const {
        unsigned char* ws = launder(ws0); float* out = launder(out0);
        const float* gate = (const float*)(ws + WS_MOD) + gate_off; const float* cs_sc = (const float*)(ws + WS_MOD) + cs_off; bf16_t* XN = (bf16_t*)(ws + WS_XN); float* xss = (float*)(ws + WS_XSS);
        const int pm = u.pm, pn = u.pn; const int cond = pm < 16 ? 0 : 1 + ((pm - 16) >> 3);
        const int rbase = pm * 256 + wr * 64 + fr;
        const bool nxt = cs_g != nullptr;
        f32x4 gt[2][2], cs[2][2];
#pragma unroll
        for (int bj = 0; bj < 2; ++bj)
#pragma unroll
            for (int n = 0; n < 2; ++n) { const int col = 256 * pn + 128 * bj + 32 * wc + 8 * fq + 4 * n; gt[bj][n] = *(const f32x4*)(gate + cond * 6144 + col);
                if (nxt) cs[bj][n] = *(const f32x4*)(cs_g + col) * (*(const f32x4*)(cs_sc + cond * 6144 + col) + 1.0f); else cs[bj][n] = (f32x4){0.f, 0.f, 0.f, 0.f}; }
#pragma unroll
        for (int ai = 0; ai < 2; ++ai)
#pragma unroll
            for (int m = 0; m < 4; ++m) {
                const int row = rbase + ai * 128 + m * 16;
                const float* bp = (row < 4096 ? base_p + (size_t)row * 1024 : base_s + (size_t)(row - 4096) * 1024);
                float ss = 0.f;
#pragma unroll
                for (int bj = 0; bj < 2; ++bj) {
                    const int col = 256 * pn + 128 * bj + 32 * wc + 8 * fq;
                    const f32x4 x0 = *(const f32x4*)(bp + col) + gt[bj][0] * acc[ai][bj][m][0], x1 = *(const f32x4*)(bp + col + 4) + gt[bj][1] * acc[ai][bj][m][1];
                    *(f32x4*)(out + (size_t)row * 1024 + col) = x0; *(f32x4*)(out + (size_t)row * 1024 + col + 4) = x1;
                    if (nxt) {
                        ss += sum4(x0 * x0) + sum4(x1 * x1);
                        const f32x4 a = x0 * cs[bj][0], b = x1 * cs[bj][1];
                        u32x4 w; w.x = pk2(a[0], a[1]); w.y = pk2(a[2], a[3]); w.z = pk2(b[0], b[1]); w.w = pk2(b[2], b[3]);
                        *(u32x4*)(XN + (size_t)row * 1024 + col) = w;
                    }
                }
                if (nxt) { ss += __shfl_xor(ss, 16); ss += __shfl_xor(ss, 32); if (fq == 0) xss[(size_t)row * 16 + 4 * pn + wc] = ss; }
                MEMFENCE();
            }
    }
};

struct EpiUp {
    static constexpr bool HOOK = false;
    unsigned char* ws0; int layer;
    __device__ __forceinline__ void hook(Acc&, const Unit&, int, int, int, int, int) const {}
    __device__ __forceinline__ void operator()(const Acc& acc, const Unit& u, int wr, int wc, int fr, int fq) const {
        unsigned char* ws = launder(ws0);
        const float* xss = (const float*)(ws + WS_XSS); const float* bias = (const float*)(ws + WS_BIAS2) + (size_t)layer * 3 * 4096; bf16_t* H = (bf16_t*)(ws + WS_R1);
        const int pm = u.pm, pn = u.pn; const int cond = pm < 16 ? 0 : 1 + ((pm - 16) >> 3);
        const int rbase = pm * 256 + wr * 64 + fr;
        f32x4 bv[2][2];
#pragma unroll
        for (int bj = 0; bj < 2; ++bj)
#pragma unroll
            for (int n = 0; n < 2; ++n) bv[bj][n] = *(const f32x4*)(bias + cond * 4096 + 256 * pn + 128 * bj + 32 * wc + 8 * fq + 4 * n);
#pragma unroll
        for (int ai = 0; ai < 2; ++ai)
#pragma unroll
            for (int m = 0; m < 4; ++m) {
                const int row = rbase + ai * 128 + m * 16; const float ri = rinv16(xss + (size_t)row * 16, 1.0f / 1024.0f);
#pragma unroll
                for (int bj = 0; bj < 2; ++bj) {
                    const int col = 256 * pn + 128 * bj + 32 * wc + 8 * fq;
                    f32x4 a = acc[ai][bj][m][0] * ri + bv[bj][0], b = acc[ai][bj][m][1] * ri + bv[bj][1];
#pragma unroll
                    for (int i = 0; i < 4; ++i) { a[i] = fmaxf(a[i], 0.f); a[i] *= a[i]; b[i] = fmaxf(b[i], 0.f); b[i] *= b[i]; }
                    u32x4 w; w.x = pk2(a[0], a[1]); w.y = pk2(a[2], a[3]); w.z = pk2(b[0], b[1]); w.w = pk2(b[2], b[3]);
                    *(u32x4*)(H + (size_t)row * 4096 + col) = w;
                }
                MEMFENCE();
            }
    }
};

__device__ __forceinline__ s16x4 vtr(const LAS unsigned char* p) { return __builtin_bit_cast(s16x4, __builtin_amdgcn_ds_read_tr16_b64_v4i16((LAS v4i16_t*)p)); }
__device__ __forceinline__ bf16x8 packp(const f32x16& p, int b) {
    u32x4 w; w.x = pk2(p[8 * b + 0], p[8 * b + 1]); w.y = pk2(p[8 * b + 2], p[8 * b + 3]); w.z = pk2(p[8 * b + 4], p[8 * b + 5]); w.w = pk2(p[8 * b + 6], p[8 * b + 7]);
    return __builtin_bit_cast(bf16x8, w);
}
#define MFMA32(a, b, c) __builtin_amdgcn_mfma_f32_32x32x16_bf16((a), (b), (c), 0, 0, 0)

constexpr int DK_LP = 272, DV_LP = 320, DK_BUF = 64 * DK_LP, DV_BUF = 64 * DV_LP;
__device__ __forceinline__ void diff_unit(LAS unsigned char* lds, const bf16_t* QD, const bf16_t* KD, const bf16_t* VD, bf16_t* ACAT, int qrow0, int kr0, int NT, int h,
                                          float lam, float outscale, const float* subln, int wave0) {
    const int tid = mk_tid(wave0);
    const int lane = tid & 63, w = __builtin_amdgcn_readfirstlane(tid >> 6), r32 = lane & 31, hi = lane >> 5, c = w >> 2, wq = w & 3;
    bf16x8 qf[4];
    { const bf16_t* qp = QD + (size_t)(qrow0 + 32 * wq + r32) * 512 + h * 128 + c * 64 + hi * 8;
#pragma unroll
      for (int s = 0; s < 4; ++s) qf[s] = *(const bf16x8*)(qp + 16 * s); }
    const int srow0 = tid >> 4, sch = tid & 15;
    const bf16_t* ksrc = KD + (size_t)(kr0 + srow0) * 512 + h * 128 + sch * 8;
    const bf16_t* vsrc = VD + (size_t)(kr0 + srow0) * 512 + h * 128 + sch * 8;
    const int kdst = srow0 * DK_LP + sch * 16, vdst = 2 * DK_BUF + srow0 * DV_LP + sch * 16;
    u32x4 kst[2], vst[2];
#define D_LOAD(t) do { _Pragma("unroll") for (int p_ = 0; p_ < 2; ++p_) { kst[p_] = *(const u32x4*)(ksrc + (size_t)((t) * 64 + 32 * p_) * 512); vst[p_] = *(const u32x4*)(vsrc + (size_t)((t) * 64 + 32 * p_) * 512); } } while (0)
#define D_WRITE(b) do { _Pragma("unroll") for (int p_ = 0; p_ < 2; ++p_) { *(LAS u32x4*)(lds + (b) * DK_BUF + kdst + p_ * 32 * DK_LP) = kst[p_]; *(LAS u32x4*)(lds + (b) * DV_BUF + vdst + p_ * 32 * DV_LP) = vst[p_]; } } while (0)
    D_LOAD(0); D_WRITE(0);
    __syncthreads();
    f32x16 o[4];
#pragma unroll
    for (int d = 0; d < 4; ++d)
#pragma unroll
        for (int r = 0; r < 16; ++r) o[d][r] = 0.f;
    float lsum = 0.f;
    const int kfoff = r32 * DK_LP + c * 128 + hi * 16;
    const int g4 = lane >> 4, i16 = lane & 15;
    const int vfoff = 2 * DK_BUF + (4 * (g4 >> 1) + (i16 >> 2)) * DV_LP + (16 * (g4 & 1) + 4 * (i16 & 3)) * 2;
    for (int t = 0; t < NT; ++t) {
        const int b = t & 1;
        if (t + 1 < NT) D_LOAD(t + 1);
        f32x16 p0, p1;
#pragma unroll
        for (int r = 0; r < 16; ++r) { p0[r] = 0.f; p1[r] = 0.f; }
        const LAS unsigned char* kb = lds + b * DK_BUF + kfoff;
#pragma unroll
        for (int s = 0; s < 4; ++s) {
            const bf16x8 k0 = *(const LAS bf16x8*)(kb + s * 32), k1 = *(const LAS bf16x8*)(kb + 32 * DK_LP + s * 32);
            p0 = MFMA32(k0, qf[s], p0); p1 = MFMA32(k1, qf[s], p1);
        }
        __builtin_amdgcn_sched_barrier(0);
        float ls = 0.f;
#pragma unroll
        for (int r = 0; r < 16; ++r) { p0[r] = __builtin_amdgcn_exp2f(p0[r]); p1[r] = __builtin_amdgcn_exp2f(p1[r]); ls += p0[r] + p1[r]; }
        lsum += ls;
        __builtin_amdgcn_sched_barrier(0);
        const LAS unsigned char* vb = lds + b * DV_BUF + vfoff;
#pragma unroll
        for (int ks = 0; ks < 4; ++ks) {
            const bf16x8 pa = (ks < 2) ? packp(p0, ks & 1) : packp(p1, ks & 1);
#pragma unroll
            for (int dt = 0; dt < 4; ++dt) {
                const s16x4 lo = vtr(vb + ks * 16 * DV_LP + dt * 64), hh = vtr(vb + ks * 16 * DV_LP + 8 * DV_LP + dt * 64);
                const bf16x8 vf = (bf16x8){lo[0], lo[1], lo[2], lo[3], hh[0], hh[1], hh[2], hh[3]};
                o[dt] = MFMA32(pa, vf, o[dt]);
            }
            __builtin_amdgcn_sched_barrier(0);
        }
        if (t + 1 < NT) D_WRITE(b ^ 1);
        __syncthreads();
    }
#undef D_LOAD
#undef D_WRITE
    lsum += __shfl_xor(lsum, 32);
    const float linv = 1.0f / lsum;
#pragma unroll
    for (int r = 0; r < 16; ++r) { const float l_ = __shfl(linv, crow(r, hi));
#pragma unroll
        for (int dt = 0; dt < 4; ++dt) o[dt][r] *= l_; }
    LAS float* xch = (LAS float*)lds;
    if (c == 1) {
#pragma unroll
        for (int dt = 0; dt < 4; ++dt)
#pragma unroll
            for (int r = 0; r < 16; ++r) xch[((wq * 4 + dt) * 16 + r) * 64 + lane] = o[dt][r];
    }
    __syncthreads();
    if (c == 0) {
        float ss[16];
#pragma unroll
        for (int r = 0; r < 16; ++r) ss[r] = 0.f;
#pragma unroll
        for (int dt = 0; dt < 4; ++dt)
#pragma unroll
            for (int r = 0; r < 16; ++r) { const float v = o[dt][r] - lam * xch[((wq * 4 + dt) * 16 + r) * 64 + lane]; o[dt][r] = v; ss[r] += v * v; }
#pragma unroll
        for (int r = 0; r < 16; ++r) {
            float s = ss[r];
            s += __shfl_xor(s, 1); s += __shfl_xor(s, 2); s += __shfl_xor(s, 4); s += __shfl_xor(s, 8); s += __shfl_xor(s, 16);
            ss[r] = rsqrtf(s * (1.0f / 128.0f) + EPSF) * outscale;
        }
#pragma unroll
        for (int dt = 0; dt < 4; ++dt) {
            const float gsl = subln[32 * dt + r32];
#pragma unroll
            for (int r = 0; r < 16; ++r) {
                const float v = o[dt][r] * ss[r] * gsl;
                ACAT[(size_t)(qrow0 + 32 * wq + crow(r, hi)) * 1536 + 512 + h * 128 + 32 * dt + r32] = (bf16_t)(pk2(v, 0.f) & 0xffffu);
            }
        }
    }
    __syncthreads();
}

constexpr int MK_LP = 208, MV_LP = 192, MK_BUF = 64 * MK_LP, MV_BUF = 64 * MV_LP;
__device__ __forceinline__ void mla_unit(LAS unsigned char* lds, const bf16_t* QM, const float* qss, const float* cqpart, const bf16_t* KM, const bf16_t* VM, bf16_t* ACAT,
                                         int qrow0, int kr0, int NT, int h, int wave0) {
    const int tid = mk_tid(wave0);
    const int lane = tid & 63, w = __builtin_amdgcn_readfirstlane(tid >> 6), r32 = lane & 31, hi = lane >> 5;
    bf16x8 qf[6];
    {
        const int row = qrow0 + 32 * w + r32;
        const f32x4 c0 = *(const f32x4*)(cqpart + (size_t)row * 8), c1 = *(const f32x4*)(cqpart + (size_t)row * 8 + 4);
        const float r1 = rsqrtf((sum4(c0) + sum4(c1)) * (1.0f / 384.0f) + EPSF);
        const float qs = qss[(size_t)row * 24 + 3 * h] + qss[(size_t)row * 24 + 3 * h + 1] + qss[(size_t)row * 24 + 3 * h + 2];
        const float sq = r1 * rsqrtf(r1 * r1 * qs * (1.0f / 96.0f) + EPSF);
        const float fq_ = sq * 0.10206207261596575f * LOG2E;
        const bf16_t* qp = QM + (size_t)row * 768 + 96 * h + hi * 8;
#pragma unroll
        for (int s = 0; s < 6; ++s) {
            const u32x4 q = *(const u32x4*)(qp + 16 * s);
            u32x4 z; z.x = pk2(bflo(q.x) * fq_, bfhi(q.x) * fq_); z.y = pk2(bflo(q.y) * fq_, bfhi(q.y) * fq_); z.z = pk2(bflo(q.z) * fq_, bfhi(q.z) * fq_); z.w = pk2(bflo(q.w) * fq_, bfhi(q.w) * fq_);
            qf[s] = __builtin_bit_cast(bf16x8, z);
        }
    }
    const int kr_a = tid / 12, kc_a = tid - 12 * kr_a; const int cb = 512 + tid; const int kr_b = cb / 12, kc_b = cb - 12 * kr_b; const bool has_b = tid < 256;
    const bf16_t* ksrc_a = KM + (size_t)(kr0 + kr_a) * 768 + 96 * h + kc_a * 8;
    const bf16_t* ksrc_b = KM + (size_t)(kr0 + kr_b) * 768 + 96 * h + kc_b * 8;
    const bf16_t* vsrc = VM + (size_t)(kr0 + (tid >> 3)) * 512 + 64 * h + (tid & 7) * 8;
    const int kdst_a = kr_a * MK_LP + kc_a * 16, kdst_b = kr_b * MK_LP + kc_b * 16, vdst = 2 * MK_BUF + (tid >> 3) * MV_LP + (tid & 7) * 16;
    u32x4 ka, kb2, vv;
#define M_LOAD(t) do { ka = *(const u32x4*)(ksrc_a + (size_t)(t) * 64 * 768); if (has_b) kb2 = *(const u32x4*)(ksrc_b + (size_t)(t) * 64 * 768); vv = *(const u32x4*)(vsrc + (size_t)(t) * 64 * 512); } while (0)
#define M_WRITE(b) do { *(LAS u32x4*)(lds + (b) * MK_BUF + kdst_a) = ka; if (has_b) *(LAS u32x4*)(lds + (b) * MK_BUF + kdst_b) = kb2; *(LAS u32x4*)(lds + (b) * MV_BUF + vdst) = vv; } while (0)
    M_LOAD(0); M_WRITE(0);
    __syncthreads();
    f32x16 o[2];
#pragma unroll
    for (int d = 0; d < 2; ++d)
#pragma unroll
        for (int r = 0; r < 16; ++r) o[d][r] = 0.f;
    float lsum = 0.f;
    const int kfoff = r32 * MK_LP + hi * 16;
    const int g4 = lane >> 4, i16 = lane & 15;
    const int vfoff = 2 * MK_BUF + (4 * (g4 >> 1) + (i16 >> 2)) * MV_LP + (16 * (g4 & 1) + 4 * (i16 & 3)) * 2;
    for (int t = 0; t < NT; ++t) {
        const int b = t & 1;
        if (t + 1 < NT) M_LOAD(t + 1);
        f32x16 p0, p1;
#pragma unroll
        for (int r = 0; r < 16; ++r) { p0[r] = 0.f; p1[r] = 0.f; }
        const LAS unsigned char* kb = lds + b * MK_BUF + kfoff;
#pragma unroll
        for (int s = 0; s < 6; ++s) {
            const bf16x8 k0 = *(const LAS bf16x8*)(kb + s * 32), k1 = *(const LAS bf16x8*)(kb + 32 * MK_LP + s * 32);
            p0 = MFMA32(k0, qf[s], p0); p1 = MFMA32(k1, qf[s], p1);
        }
        float ls = 0.f;
#pragma unroll
        for (int r = 0; r < 16; ++r) { p0[r] = __builtin_amdgcn_exp2f(p0[r]); p1[r] = __builtin_amdgcn_exp2f(p1[r]); ls += p0[r] + p1[r]; }
        lsum += ls;
        const LAS unsigned char* vb = lds + b * MV_BUF + vfoff;
#pragma unroll
        for (int ks = 0; ks < 4; ++ks) {
            const bf16x8 pa = (ks < 2) ? packp(p0, ks & 1) : packp(p1, ks & 1);
#pragma unroll
            for (int dt = 0; dt < 2; ++dt) {
                const s16x4 lo = vtr(vb + ks * 16 * MV_LP + dt * 64), hh = vtr(vb + ks * 16 * MV_LP + 8 * MV_LP + dt * 64);
                const bf16x8 vf = (bf16x8){lo[0], lo[1], lo[2], lo[3], hh[0], hh[1], hh[2], hh[3]};
                o[dt] = MFMA32(pa, vf, o[dt]);
            }
        }
        if (t + 1 < NT) M_WRITE(b ^ 1);
        __syncthreads();
    }
#undef M_LOAD
#undef M_WRITE
    lsum += __shfl_xor(lsum, 32);
    const float linv = 1.0f / lsum;
#pragma unroll
    for (int r = 0; r < 16; ++r) {
        const float l = __shfl(linv, crow(r, hi));
#pragma unroll
        for (int dt = 0; dt < 2; ++dt) {
            const float v = o[dt][r] * l;
            ACAT[(size_t)(qrow0 + 32 * w + crow(r, hi)) * 1536 + 1024 + 64 * h + 32 * dt + r32] = (bf16_t)(pk2(v, 0.f) & 0xffffu);
        }
    }
}

__device__ __forceinline__ void conv_item(LAS unsigned char* lds, const bf16_t* U, const float* dw, const float* cb, const float* gn, bf16_t* ACAT, int item, int wave0) {
    const int tid = mk_tid(wave0);
    const int lane = tid & 63, w = __builtin_amdgcn_readfirstlane(tid >> 6);
    const int t0 = item * 32;
    const int sstart = t0 < 4096 ? (t0 & ~255) : 4096 + ((t0 - 4096) & ~2047), send = sstart + (t0 < 4096 ? 256 : 2048);
    LAS bf16_t* ub = (LAS bf16_t*)lds;
    LAS float* red = (LAS float*)(lds + 65536);
    LAS float* rinvs = (LAS float*)(lds + 65536 + 1024);
    for (int cidx = tid; cidx < 62 * 64; cidx += 512) {
        const int r = cidx >> 6, ch = cidx & 63, row = t0 - 15 + r;
        u32x4 v = (u32x4){0u, 0u, 0u, 0u};
        if (row >= sstart && row < send) v = *(const u32x4*)(U + (size_t)row * 512 + ch * 8);
        *(LAS u32x4*)(lds + r * 1024 + ch * 16) = v;
    }
    float wv[31];
#pragma unroll
    for (int j = 0; j < 31; ++j) wv[j] = dw[j * 512 + tid];
    const float bias = cb[tid];
    __syncthreads();
    float y[32];
#pragma unroll
    for (int t = 0; t < 32; ++t) y[t] = bias;
#pragma unroll
    for (int r = 0; r < 62; ++r) {
        const float x = __uint_as_float(((unsigned)ub[r * 512 + tid]) << 16);
#pragma unroll
        for (int t = 0; t < 32; ++t) { if (r - t >= 0 && r - t <= 30) y[t] += wv[r - t] * x; }
    }
#pragma unroll
    for (int t = 0; t < 32; ++t) { const float s = wave_sum(y[t] * y[t]); if (lane == 0) red[t * 8 + w] = s; }
    __syncthreads();
    if (tid < 32) { float s = 0.f;
#pragma unroll
        for (int k = 0; k < 8; ++k) s += red[tid * 8 + k];
        rinvs[tid] = rsqrtf(s * (1.0f / 512.0f) + EPSF); }
    __syncthreads();
    const float g = gn[tid];
#pragma unroll
    for (int t = 0; t < 32; ++t) {
        const float v = y[t] * rinvs[t] * g; const float sv = v * sigmoidf_(v);
        ACAT[(size_t)(t0 + t) * 1536 + tid] = (bf16_t)(pk2(sv, 0.f) & 0xffffu);
    }
    __syncthreads();
}

__device__ __forceinline__ int perm_off(int type, int rho) {
    const int n = rho >> 4, fq = (rho >> 2) & 3, i = rho & 3;
    return type == 0 ? rho : (type == 1 ? 8 * fq + 4 * n + i : 16 * (fq >> 1) + 8 * n + 4 * (fq & 1) + i);
}
__device__ __forceinline__ void tr_item(const float* W, int ldw, int k0, int n0, bf16_t* WT, int ldt, int drow0, int dk0, int ptype, const float* ksc, LAS float* scr, int lane) {
#pragma unroll 8
    for (int i = 0; i < 32; ++i) { const int kk = 2 * i + (lane >> 5); float v = 0.f; if (n0 >= 0) v = W[(size_t)(k0 + kk) * ldw + n0 + (lane & 31)]; if (ksc) v *= ksc[k0 + kk]; scr[kk * 33 + (lane & 31)] = v; }
    LDS_WAIT(); asm volatile("" ::: "memory");
    const int c = lane & 7;
#pragma unroll
    for (int j = 0; j < 4; ++j) { const int rho = (lane >> 3) + 8 * j; const LAS float* s = scr + (8 * c) * 33 + perm_off(ptype, rho);
        u32x4 o; o.x = pk2(s[0 * 33], s[1 * 33]); o.y = pk2(s[2 * 33], s[3 * 33]); o.z = pk2(s[4 * 33], s[5 * 33]); o.w = pk2(s[6 * 33], s[7 * 33]);
        *(u32x4*)(WT + (size_t)(drow0 + rho) * ldt + dk0 + 8 * c) = o; }
    LDS_WAIT(); asm volatile("" ::: "memory");
}
__device__ __forceinline__ void gemv3_item(const float* W, int ldw, int ncols, int n0, const LAS float* vec, LAS float* red, float* o0, float* o1, float* o2, const float* addb, int wave, int lane) {
    const int n = n0 + lane; const bool ok = n < ncols;
    float a0 = 0.f, a1 = 0.f, a2 = 0.f;
    const float* wp = W + (size_t)(128 * wave) * ldw + (ok ? n : n0);
#pragma unroll 8
    for (int kk = 0; kk < 128; ++kk) { const float wv = wp[(size_t)kk * ldw]; const int k = 128 * wave + kk; a0 += vec[k] * wv; a1 += vec[1024 + k] * wv; a2 += vec[2048 + k] * wv; }
    red[(wave * 3 + 0) * 64 + lane] = a0; red[(wave * 3 + 1) * 64 + lane] = a1; red[(wave * 3 + 2) * 64 + lane] = a2;
    __syncthreads();
    if (wave < 3) { float s = 0.f;
#pragma unroll
        for (int k = 0; k < 8; ++k) s += red[(k * 3 + wave) * 64 + lane];
        if (addb && ok) s += addb[n];
        float* op = wave == 0 ? o0 : (wave == 1 ? o1 : o2);
        if (ok) op[n] = s; }
    __syncthreads();
}

#define XB_TMO      128
#define XB_XCNT(j)  (256  + 64 * (j))
#define XB_XSUB(j)  (1280 + 64 * (j))
#define XB_XGEN(j)  (2304 + 64 * (j))
#define XB_TOP      3328
#define XB_TOPGEN   3392
#define XCD_BAR_WORDS 3456
#define XB_SPIN_CAP (1u << 18)
__device__ __forceinline__ unsigned xb_ld(unsigned* p)              { return __hip_atomic_load(p, __ATOMIC_RELAXED, __HIP_MEMORY_SCOPE_AGENT); }
__device__ __forceinline__ unsigned xb_add(unsigned* p, unsigned v) { return __hip_atomic_fetch_add(p, v, __ATOMIC_RELAXED, __HIP_MEMORY_SCOPE_AGENT); }
__device__ __forceinline__ unsigned xb_xcc_id() { return (unsigned)__builtin_amdgcn_s_getreg((3 << 11) | 20) & 0xFu; }
#define XB_SPIN(cond, bar) do { unsigned _sp = 0; while (cond) { __builtin_amdgcn_s_sleep(1); \
    if ((++_sp & 255u) == 0u) { if (xb_ld(&(bar)[XB_TMO])) break; if (_sp > XB_SPIN_CAP) { atomicAdd(&(bar)[XB_TMO], 1u); break; } } } } while (0)
struct XcdBarrier { unsigned* bar; unsigned x; volatile LAS unsigned* st; };
__device__ __forceinline__ XcdBarrier xcd_barrier_post(unsigned* bar, volatile LAS unsigned* st, int tid) {
    XcdBarrier b; b.bar = bar; b.x = xb_xcc_id(); b.st = st;
    if (tid == 0) (void)xb_add(&bar[XB_XCNT(b.x)], 1u);
    return b;
}
__device__ __forceinline__ void xcd_barrier_complete(unsigned* bar, unsigned x, unsigned& nloc, unsigned& nx) {
    const unsigned G = gridDim.x * gridDim.y * gridDim.z;
    unsigned sum, cnt, mine, sp = 0u;
    for (;;) {
        sum = 0u; cnt = 0u; mine = 0u;
#pragma unroll
        for (unsigned j = 0; j < 16; ++j) { const unsigned c = xb_ld(&bar[XB_XCNT(j)]); sum += c; cnt += (c > 0u) ? 1u : 0u; mine = (j == x) ? c : mine; }
        if (sum == G) break;
        __builtin_amdgcn_s_sleep(1);
        if ((++sp & 255u) == 0u) { if (xb_ld(&bar[XB_TMO])) break; if (sp > XB_SPIN_CAP) { atomicAdd(&bar[XB_TMO], 1u); break; } }
    }
    nloc = mine > 0u ? mine : 1u; nx = cnt > 0u ? cnt : 1u;
}
__device__ __forceinline__ void xcd_barrier(const XcdBarrier& b, int tid) {
    asm volatile("s_waitcnt vmcnt(0)" ::: "memory");
    __syncthreads();
    if (tid == 0) {
        unsigned* bar = b.bar;
        __builtin_amdgcn_s_waitcnt(0);
        unsigned nloc = b.st[0], nx = b.st[1];
        if (nloc == 0u) { xcd_barrier_complete(bar, b.x, nloc, nx); b.st[0] = nloc; b.st[1] = nx; }
        const unsigned old = xb_add(&bar[XB_XSUB(b.x)], 1u);
        const unsigned gen = old / nloc;
        if (old + 1u == (gen + 1u) * nloc) {
            __builtin_amdgcn_fence(__ATOMIC_RELEASE, "agent");
            asm volatile("s_waitcnt vmcnt(0)" ::: "memory");
            const unsigned og = xb_add(&bar[XB_TOP], 1u);
            const unsigned tg = og / nx;
            if (og + 1u == (tg + 1u) * nx) xb_add(&bar[XB_TOPGEN], 1u);
            else XB_SPIN(xb_ld(&bar[XB_TOPGEN]) == tg, bar);
            __builtin_amdgcn_fence(__ATOMIC_ACQUIRE, "agent");
            xb_add(&bar[XB_XGEN(b.x)], 1u);
            asm volatile("s_waitcnt vmcnt(0)" ::: "memory");
        } else {
            XB_SPIN(xb_ld(&bar[XB_XGEN(b.x)]) == gen, bar);
            __builtin_amdgcn_fence(__ATOMIC_ACQUIRE, "agent");
            asm volatile("s_waitcnt vmcnt(0)" ::: "memory");
        }
    }
    __syncthreads();
}

struct Args { const float* in[32]; float* out; unsigned char* ws; int ph_lo, ph_hi; };
enum { I_XP = 0, I_XS, I_CDK, I_CDV, I_CCKV, I_CKPE, I_C, I_CCTX, I_MODW, I_MODB, I_N1G, I_WIN, I_CDW, I_CB, I_CNG, I_WCO, I_DQN, I_DKN, I_DLAM, I_DSUB, I_WDO,
       I_QAN, I_KVAN, I_WUQ, I_WUKV, I_MQN, I_MKN, I_WMO, I_WOUT, I_N2G, I_WUP, I_WDOWN };
constexpr int NPHASES = 18;

#define TAB_OFF (LDSCTL_OFF + 256)
__device__ __forceinline__ const float* inp(LAS unsigned char* lds, int i) {
    const unsigned long long v = ((volatile LAS unsigned long long*)(lds + TAB_OFF))[i];
    const unsigned lo = __builtin_amdgcn_readfirstlane((unsigned)v), hi = __builtin_amdgcn_readfirstlane((unsigned)(v >> 32));
    return (const float*)(((unsigned long long)hi << 32) | lo);
}

__device__ __forceinline__ void convert_layer(LAS unsigned char* lds, unsigned char* ws, int l, int gw, int NGW, int gtid, int NGT, int lane, int wave) {
    LAS float* scr = (LAS float*)(lds + wave * 16384);
    constexpr int I1 = 200 * 16, I2A = 24 * 6, I2B = 32 * 4, I4 = 32 * 24, I5 = 32 * 16, I6 = 128 * 16, I7 = 32 * 64;
    constexpr int NITEMS = I1 + I2A + I2B + I4 + I5 + I6 + I7;
    for (int it = gw; it < NITEMS; it += NGW) {
        int r = it;
        if (r < I1) { const int db = r >> 4, kb = r & 15; const int pn = db >> 3, bj = (db >> 2) & 1, wc = db & 3; int n0, pt = 1;
            if (pn < 4) n0 = bj * 512 + 128 * pn + 32 * wc;
            else if (pn < 8) { n0 = (pn < 6 ? 1024 : 1536) + 256 * ((pn - 4) & 1) + 64 * wc + 32 * bj; pt = 0; }
            else if (pn < 10) n0 = 2048 + 256 * (pn - 8) + 128 * bj + 32 * wc;
            else if (pn == 10) n0 = 2560 + 128 * bj + 32 * wc;
            else if (pn == 11) n0 = bj == 0 ? 2816 + 32 * wc : (wc == 0 ? 3200 : -1);
            else if (pn == 12) n0 = 2944 + 128 * bj + 32 * wc;
            else n0 = 3232 + 256 * (pn - 13) + 128 * bj + 32 * wc;
            tr_item(inp(lds, I_WIN) + (size_t)l * 1024 * NIN, NIN, 64 * kb, n0, (bf16_t*)(ws + WS_BT1), 1024, 32 * db, 64 * kb, pt, nullptr, scr, lane); continue; } r -= I1;
        if (r < I2A) { const int blk = r / 6, kb = r - 6 * blk; const int h = blk / 3, part = blk - 3 * h;
            tr_item(inp(lds, I_WUQ) + (size_t)l * 384 * 768, 768, 64 * kb, 96 * h + 32 * part, (bf16_t*)(ws + WS_BT2A), 384, 32 * blk, 64 * kb, part == 2 ? 2 : 0, inp(lds, I_QAN) + l * 384, scr, lane); continue; } r -= I2A;
        if (r < I2B) { const int db = r >> 2, kb = r & 3; const int pn = db >> 3, bj = (db >> 2) & 1, wc = db & 3; int n0, pt;
            if (pn < 2) { n0 = 128 * (4 * pn + wc) + 32 * bj; pt = 0; } else { n0 = 128 * (4 * (pn - 2) + 2 * bj + (wc >> 1)) + 64 + 32 * (wc & 1); pt = 1; }
            tr_item(inp(lds, I_WUKV) + (size_t)l * 256 * 1024, 1024, 64 * kb, n0, (bf16_t*)(ws + WS_BT2B), 256, 32 * db, 64 * kb, pt, inp(lds, I_KVAN) + l * 256, scr, lane); continue; } r -= I2B;
        if (r < I4) { const int db = r / 24, kb = r - 24 * db; const int sg = kb >> 3; const float* W = inp(lds, sg == 0 ? I_WCO : (sg == 1 ? I_WDO : I_WMO)) + (size_t)l * 512 * 1024;
            tr_item(W, 1024, 64 * (kb & 7), 32 * db, (bf16_t*)(ws + WS_BT4), 1536, 32 * db, 64 * kb, 1, nullptr, scr, lane); continue; } r -= I4;
        if (r < I5) { const int db = r >> 4, kb = r & 15; tr_item(inp(lds, I_WOUT) + (size_t)l * 1024 * 1024, 1024, 64 * kb, 32 * db, (bf16_t*)(ws + WS_BT5), 1024, 32 * db, 64 * kb, 1, nullptr, scr, lane); continue; } r -= I5;
        if (r < I6) { const int db = r >> 4, kb = r & 15; tr_item(inp(lds, I_WUP) + (size_t)l * 1024 * 4096, 4096, 64 * kb, 32 * db, (bf16_t*)(ws + WS_BT6), 1024, 32 * db, 64 * kb, 1, nullptr, scr, lane); continue; } r -= I6;
        { const int db = r >> 6, kb = r & 63; tr_item(inp(lds, I_WDOWN) + (size_t)l * 4096 * 1024, 1024, 64 * kb, 32 * db, (bf16_t*)(ws + WS_BT7), 4096, 32 * db, 64 * kb, 1, nullptr, scr, lane); }
    }
    bf16_t* KD = (bf16_t*)(ws + WS_KD); bf16_t* VD = (bf16_t*)(ws + WS_VD); bf16_t* CKVA = (bf16_t*)(ws + WS_CKVA);
    float* KPER = (float*)(ws + WS_KPER); float* KPESS = (float*)(ws + WS_KPESS);
    { const float* cdk = inp(lds, I_CDK); const float* cdv = inp(lds, I_CDV);
    for (int ci = gtid; ci < 512 * 64; ci += NGT) {
        const int row = ci >> 6, c8 = ci & 63, b = row >> 8, j = row & 255;
        const size_t src = ((size_t)(b * 2 + l) * 256 + j) * 512 + 8 * c8; const size_t dst = (size_t)(4096 + b * 2304 + j) * 512 + 8 * c8;
        { const f32x4 x0 = *(const f32x4*)(cdk + src), x1 = *(const f32x4*)(cdk + src + 4);
          u32x4 w; w.x = pk2(x0[0], x0[1]); w.y = pk2(x0[2], x0[3]); w.z = pk2(x1[0], x1[1]); w.w = pk2(x1[2], x1[3]); *(u32x4*)(KD + dst) = w; }
        { const f32x4 x0 = *(const f32x4*)(cdv + src), x1 = *(const f32x4*)(cdv + src + 4);
          u32x4 w; w.x = pk2(x0[0], x0[1]); w.y = pk2(x0[2], x0[3]); w.z = pk2(x1[0], x1[1]); w.w = pk2(x1[2], x1[3]); *(u32x4*)(VD + dst) = w; }
    } }
    { const float* cckv = inp(lds, I_CCKV); const float* gk = inp(lds, I_KVAN) + l * 256;
    for (int ci = gtid; ci < 512 * 32; ci += NGT) {
        const int row = ci >> 5, c8 = ci & 31, b = row >> 8, j = row & 255;
        const size_t src = ((size_t)(b * 2 + l) * 256 + j) * 256 + 8 * c8;
        const float* g = gk + 8 * c8;
        const f32x4 x0 = *(const f32x4*)(cckv + src) / *(const f32x4*)g, x1 = *(const f32x4*)(cckv + src + 4) / *(const f32x4*)(g + 4);
        u32x4 w; w.x = pk2(x0[0], x0[1]); w.y = pk2(x0[2], x0[3]); w.z = pk2(x1[0], x1[1]); w.w = pk2(x1[2], x1[3]);
        *(u32x4*)(CKVA + (size_t)(8192 + row) * 256 + 8 * c8) = w;
    } }
    { const float* ckpe = inp(lds, I_CKPE);
    for (int row = gtid; row < 512; row += NGT) {
        const int b = row >> 8, j = row & 255; const float* src = ckpe + ((size_t)(b * 2 + l) * 256 + j) * 32; float ss = 0.f;
#pragma unroll
        for (int q = 0; q < 8; ++q) { const f32x4 x = *(const f32x4*)(src + 4 * q); *(f32x4*)(KPER + (size_t)(8192 + row) * 32 + 4 * q) = x; ss += sum4(x * x); }
        KPESS[8192 + row] = ss;
    } }
}

__global__ void __launch_bounds__(512, 2) mk_fwd(Args a) {
    extern __shared__ __attribute__((aligned(16))) unsigned char lds_raw[];
    LAS unsigned char* lds = (LAS unsigned char*)lds_raw;
    const int wave0 = __builtin_amdgcn_readfirstlane(threadIdx.x >> 6);
    const int G = gridDim.x, bx = blockIdx.x;
    const int vcu = (G % 8 == 0) ? (bx % 8) * (G / 8) + bx / 8 : bx;
    const int NGW = G * 8, NGT = G * 512;
#define PH_VARS const int tid = mk_tid(wave0); const int lane = tid & 63, wave = __builtin_amdgcn_readfirstlane(tid >> 6); const int gw = vcu * 8 + wave, gtid = vcu * 512 + tid; (void)lane; (void)gw; (void)gtid;
    { const int tid = mk_tid(wave0);
    for (int u = tid; u < (LDS_BYTES - LDSCTL_OFF) / 4; u += 512) ((LAS unsigned*)(lds + LDSCTL_OFF))[u] = 0u;
    __syncthreads();
    if (tid == 0) {
        LAS unsigned long long* tab = (LAS unsigned long long*)(lds + TAB_OFF);
#define TAB_SET(i) tab[i] = (unsigned long long)(uintptr_t)a.in[i]
        TAB_SET(0); TAB_SET(1); TAB_SET(2); TAB_SET(3); TAB_SET(4); TAB_SET(5); TAB_SET(6); TAB_SET(7); TAB_SET(8); TAB_SET(9); TAB_SET(10); TAB_SET(11); TAB_SET(12); TAB_SET(13); TAB_SET(14); TAB_SET(15);
        TAB_SET(16); TAB_SET(17); TAB_SET(18); TAB_SET(19); TAB_SET(20); TAB_SET(21); TAB_SET(22); TAB_SET(23); TAB_SET(24); TAB_SET(25); TAB_SET(26); TAB_SET(27); TAB_SET(28); TAB_SET(29); TAB_SET(30); TAB_SET(31);
#undef TAB_SET
    }
    __syncthreads(); }
    volatile LAS unsigned* MISC = (volatile LAS unsigned*)(lds + LDSCTL_OFF);
    XcdBarrier bar; bar.bar = (unsigned*)(a.ws + WS_CTL) + 1024; bar.x = 0; bar.st = nullptr;
#if !MK_PER_PHASE
    bar = xcd_barrier_post((unsigned*)(a.ws + WS_CTL) + 1024, MISC + 8, mk_tid(wave0));
#define GRID_BAR() xcd_barrier(bar, mk_tid(wave0))
#else
#define GRID_BAR() do {} while (0)
#endif
    const int lo = a.ph_lo, hi = a.ph_hi;
#ifndef PHMASK
#define PHMASK 0xFFFFFFFFu
#endif
#define IN(k) (((PHMASK >> ((k) < 2 ? (k) : 2 + (((k) - 2) & 7))) & 1u) && lo <= (k) && (k) < hi)
#define SEAM(k) do { if (lo <= (k) && (k) + 1 < hi) GRID_BAR(); } while (0)

    if (IN(0)) {
        PH_VARS
        unsigned char* ws = launder(a.ws);
        float* MOD = (float*)(ws + WS_MOD);
        LAS float* vec = (LAS float*)(lds + 0);
        LAS float* red = (LAS float*)(lds + 12288);
        { const float* cctx = inp(lds, I_CCTX); const float* cc = inp(lds, I_C);
          for (int k = tid; k < 3072; k += 512) { const int j = k >> 10, kk = k & 1023; const float x = j == 0 ? cctx[kk] : cc[(j - 1) * 1024 + kk]; vec[k] = x * sigmoidf_(x); } }
        __syncthreads();
        { const float* modw = inp(lds, I_MODW); const float* modb = inp(lds, I_MODB);
          for (int it = vcu; it < 192; it += G) { const int l = it / 96, n0 = 64 * (it % 96);
            gemv3_item(modw + (size_t)l * 1024 * 6144, 6144, 6144, n0, vec, red, MOD + (l * 3 + 0) * 6144, MOD + (l * 3 + 1) * 6144, MOD + (l * 3 + 2) * 6144, modb + l * 6144, wave, lane); } }
        __syncthreads();
        convert_layer(lds, ws, 0, gw, NGW, gtid, NGT, lane, wave);
        float* cosD = (float*)(ws + WS_TAB); float* sinD = cosD + 1024; float* cosM = cosD + 2048; float* sinM = cosD + 2560;
        for (int i = gtid; i < 1024 + 512; i += NGT) {
            if (i < 1024) { const int pos = i >> 4, f = i & 15; const float inv = powf(10000.0f, -(float)f / 16.0f), ang = (float)pos * inv; cosD[i] = cosf(ang); sinD[i] = sinf(ang); }
            else { const int k = i - 1024, pos = k >> 3, f = k & 7; const float inv = powf(10000.0f, -(float)f / 8.0f), ang = (float)pos * inv; cosM[k] = cosf(ang); sinM[k] = sinf(ang); }
        }
    }
    SEAM(0);
    if (IN(1)) {
        PH_VARS
        unsigned char* ws = launder(a.ws);
        float* MOD = (float*)(ws + WS_MOD); float* BIAS1 = (float*)(ws + WS_BIAS1); float* BIAS2 = (float*)(ws + WS_BIAS2);
        bf16_t* XN = (bf16_t*)(ws + WS_XN); float* XSS = (float*)(ws + WS_XSS);
        LAS float* vec = (LAS float*)(lds + 0); LAS float* red = (LAS float*)(lds + 12288);
        { const float* wup = inp(lds, I_WUP); const float* win = inp(lds, I_WIN);
        for (int it = vcu; it < 326; it += G) {
            const int l = it / 163, r = it % 163; const bool isup = r >= 99; const int n0 = 64 * (isup ? r - 99 : r);
            __syncthreads();
            for (int k = tid; k < 3072; k += 512) { const int j = k >> 10, kk = k & 1023; vec[k] = MOD[(l * 3 + j) * 6144 + (isup ? 3072 : 0) + kk]; }
            __syncthreads();
            if (isup) gemv3_item(wup + (size_t)l * 1024 * 4096, 4096, 4096, n0, vec, red, BIAS2 + (l * 3 + 0) * 4096, BIAS2 + (l * 3 + 1) * 4096, BIAS2 + (l * 3 + 2) * 4096, nullptr, wave, lane);
            else gemv3_item(win + (size_t)l * 1024 * NIN, NIN, NIN, n0, vec, red, BIAS1 + (l * 3 + 0) * NIN, BIAS1 + (l * 3 + 1) * NIN, BIAS1 + (l * 3 + 2) * NIN, nullptr, wave, lane);
        } }
        { const float* xp = inp(lds, I_XP); const float* xs = inp(lds, I_XS); const float* g = inp(lds, I_N1G);
        for (int row = gw; row < MROWS; row += NGW) {
            const float* xr = row < 4096 ? xp + (size_t)row * 1024 : xs + (size_t)(row - 4096) * 1024;
            const int cond = row < 4096 ? 0 : 1 + ((row - 4096) >> 11);
            const float* sc = MOD + (0 * 3 + cond) * 6144 + 1024;
            float ss = 0.f;
#pragma unroll
            for (int j = 0; j < 4; ++j) { const int col = 256 * j + 4 * lane; const f32x4 x = *(const f32x4*)(xr + col); ss += sum4(x * x);
                const f32x4 y = x * *(const f32x4*)(g + col) * (*(const f32x4*)(sc + col) + 1.0f); u32x2 w; w.x = pk2(y[0], y[1]); w.y = pk2(y[2], y[3]); *(u32x2*)(XN + (size_t)row * 1024 + col) = w; }
            ss = wave_sum(ss);
            if (lane < 16) XSS[(size_t)row * 16 + lane] = lane == 0 ? ss : 0.f;
        } }
    }
    SEAM(1);

    for (int l = 0; l < 2; ++l) {
        const int P = 2 + 8 * l;
        if (IN(P + 0)) {
            unsigned char* ws = launder(a.ws);
            pg8::Gemm g{(const bf16_t*)(ws + WS_XN), (const bf16_t*)(ws + WS_BT1), MROWS, NINP, 1024}; pg8::StaticOrder S; S.init(MROWS, NINP, G, bx);
            EpiIn E{ws, a.out, inp(lds, I_DQN) + l * 64, inp(lds, I_DKN) + l * 64, l};
            pg8::gemm_phase<EpiIn, true>(lds, g, S, E, wave0);
        }
        SEAM(P + 0);
        if (IN(P + 1)) {
#if !defined(P2SUB) || P2SUB == 0
            { unsigned char* ws = launder(a.ws);
              pg8::Gemm g{(const bf16_t*)(ws + WS_CQ), (const bf16_t*)(ws + WS_BT2A), MROWS, 768, 384}; pg8::StaticOrder S; S.init(MROWS, 768, G, bx);
              EpiQM E{ws, inp(lds, I_MQN) + l * 96};
              pg8::gemm_phase<EpiQM, false>(lds, g, S, E, wave0); }
#endif
#if !defined(P2SUB) || P2SUB == 1
            { unsigned char* ws = launder(a.ws);
              pg8::Gemm g{(const bf16_t*)(ws + WS_CKVA), (const bf16_t*)(ws + WS_BT2B), KROWS, 1024, 256}; pg8::StaticOrder S; S.init(KROWS, 1024, G, (bx + 160) % G);
              EpiKV E{ws, a.out, inp(lds, I_MKN) + l * 96, inp(lds, I_KVAN) + l * 256, l};
              pg8::gemm_phase<EpiKV, false>(lds, g, S, E, wave0); }
#endif
#if !defined(P2SUB) || P2SUB == 2
            { unsigned char* ws = launder(a.ws);
              const float* dw = inp(lds, I_CDW) + (size_t)l * 31 * 512; const float* cb = inp(lds, I_CB) + l * 512; const float* cg = inp(lds, I_CNG) + l * 512;
              for (int it = vcu; it < 256; it += G) conv_item(lds, (const bf16_t*)(ws + WS_U), dw, cb, cg, (bf16_t*)(ws + WS_ACAT), it, wave0); }
#endif
        }
        SEAM(P + 1);
        if (IN(P + 2)) {
            PH_VARS
            unsigned char* ws = launder(a.ws);
            const bf16_t* QD = (const bf16_t*)(ws + WS_QD); const bf16_t* KD = (const bf16_t*)(ws + WS_KD); const bf16_t* VD = (const bf16_t*)(ws + WS_VD);
            const bf16_t* QM = (const bf16_t*)(ws + WS_QM); const bf16_t* KM = (const bf16_t*)(ws + WS_KM); const bf16_t* VM = (const bf16_t*)(ws + WS_VM);
            const float* QSS = (const float*)(ws + WS_QSS); const float* CQP = (const float*)(ws + WS_CQP); bf16_t* ACAT = (bf16_t*)(ws + WS_ACAT);
            const float lam_init = l == 0 ? 0.2f : 0.35550906759f;
            float lam;
            { const float* lp = inp(lds, I_DLAM) + l * 256; const float s1 = wave_sum(lp[lane] * lp[64 + lane]), s2 = wave_sum(lp[128 + lane] * lp[192 + lane]); lam = __expf(s1) - __expf(s2) + lam_init; }
            const float* subln = inp(lds, I_DSUB) + l * 128;
            for (int c = vcu; c < 256; c += G) {
                if (c < 128) {
                    { const int b = c >> 6, h = (c >> 4) & 3, qb = c & 15; diff_unit(lds, QD, KD, VD, ACAT, 4096 + 2048 * b + 128 * qb, 4096 + 2304 * b, 36, h, lam, 1.0f - lam_init, subln, wave0); }
                    { const int b = c >> 3, h = c & 7; mla_unit(lds, QM, QSS, CQP, KM, VM, ACAT, 256 * b, 256 * b, 4, h, wave0); }
                } else {
                    const int i = c - 128;
                    { const int b = i >> 6, h = (i >> 3) & 7, qb = i & 7; mla_unit(lds, QM, QSS, CQP, KM, VM, ACAT, 4096 + 2048 * b + 256 * qb, 4096 + 2304 * b, 36, h, wave0); }
                    { const int b = i >> 3, h = (i >> 1) & 3, qb = i & 1; diff_unit(lds, QD, KD, VD, ACAT, 256 * b + 128 * qb, 256 * b, 4, h, lam, 1.0f - lam_init, subln, wave0); }
                }
            }
        }
        SEAM(P + 2);
        if (IN(P + 3)) {
            unsigned char* ws = launder(a.ws);
            pg8::Gemm g{(const bf16_t*)(ws + WS_ACAT), (const bf16_t*)(ws + WS_BT4), MROWS, 1024, 1536}; pg8::StaticOrder S; S.init(MROWS, 1024, G, bx);
            EpiMerge E{ws};
            pg8::gemm_phase<EpiMerge, false>(lds, g, S, E, wave0);
        }
        SEAM(P + 3);
        if (IN(P + 4)) {
            unsigned char* ws = launder(a.ws);
            pg8::Gemm g{(const bf16_t*)(ws + WS_MG), (const bf16_t*)(ws + WS_BT5), MROWS, 1024, 1024}; pg8::StaticOrder S; S.init(MROWS, 1024, G, bx);
            EpiRes E{l == 0 ? inp(lds, I_XP) : a.out, l == 0 ? inp(lds, I_XS) : a.out + (size_t)4096 * 1024, a.out, ws, l * 3 * 6144 + 2048, inp(lds, I_N2G) + l * 1024, l * 3 * 6144 + 4096};
            pg8::gemm_phase<EpiRes, false>(lds, g, S, E, wave0);
        }
        SEAM(P + 4);
        if (IN(P + 5)) {
            unsigned char* ws = launder(a.ws);
            pg8::Gemm g{(const bf16_t*)(ws + WS_XN), (const bf16_t*)(ws + WS_BT6), MROWS, 4096, 1024}; pg8::StaticOrder S; S.init(MROWS, 4096, G, bx);
            EpiUp E{ws, l};
            pg8::gemm_phase<EpiUp, true>(lds, g, S, E, wave0);
        }
        SEAM(P + 5);
        if (IN(P + 6)) {
            unsigned char* ws = launder(a.ws);
            pg8::Gemm g{(const bf16_t*)(ws + WS_R1), (const bf16_t*)(ws + WS_BT7), MROWS, 1024, 4096}; pg8::StaticOrder S; S.init(MROWS, 1024, G, bx);
            EpiRes E{a.out, a.out + (size_t)4096 * 1024, a.out, ws, l * 3 * 6144 + 5120, l == 0 ? inp(lds, I_N1G) + 1024 : nullptr, 3 * 6144 + 1024};
            pg8::gemm_phase<EpiRes, false>(lds, g, S, E, wave0);
        }
        if (l == 0) {
            SEAM(P + 6);
            if (IN(P + 7)) { PH_VARS unsigned char* ws = launder(a.ws); convert_layer(lds, ws, 1, gw, NGW, gtid, NGT, lane, wave); }
            SEAM(P + 7);
        }
    }
#undef IN
#undef SEAM
}

extern "C" void kernel_launch(void* const* d_in, const int* in_sizes, int n_in, void* d_out, int out_size, void* d_ws, size_t ws_size, hipStream_t stream) {
    static int grid = 0;
    if (grid == 0) {
        if (n_in != 32 || out_size != 19136512 || ws_size < WS_END) { fprintf(stderr, "kernel_launch: unexpected shapes (n_in %d out %d ws %zu)\n", n_in, out_size, ws_size); grid = -1; return; }
        int dev = 0, cus = 0;
        if (hipGetDevice(&dev) != hipSuccess || hipDeviceGetAttribute(&cus, hipDeviceAttributeMultiprocessorCount, dev) != hipSuccess) { grid = -1; return; }
        if (hipFuncSetAttribute((const void*)mk_fwd, hipFuncAttributeMaxDynamicSharedMemorySize, LDS_BYTES) != hipSuccess) { fprintf(stderr, "kernel_launch: hipFuncSetAttribute failed\n"); grid = -1; return; }
        int per_cu = 0;
        if (hipOccupancyMaxActiveBlocksPerMultiprocessor(&per_cu, (const void*)mk_fwd, 512, LDS_BYTES) != hipSuccess || per_cu < 1) fprintf(stderr, "kernel_launch: occupancy query reports %d\n", per_cu);
        (void)hipGetLastError();
        grid = cus;
    }
    if (grid < 0) return;
    (void)hipMemsetAsync((char*)d_ws + WS_CTL, 0, CTL_ZERO_BYTES, stream);
    Args a{};
    for (int i = 0; i < 32; ++i) a.in[i] = (const float*)d_in[i];
    a.out = (float*)d_out; a.ws = (unsigned char*)d_ws;
#if MK_PER_PHASE
    for (int p = 0; p < NPHASES; ++p) { a.ph_lo = p; a.ph_hi = p + 1; hipLaunchKernelGGL(mk_fwd, dim3(grid), dim3(512), LDS_BYTES, stream, a); }
#else
    a.ph_lo = 0; a.ph_hi = NPHASES;
    hipLaunchKernelGGL(mk_fwd, dim3(grid), dim3(512), LDS_BYTES, stream, a);
#endif
}
```

```cpp
#include <hip/hip_runtime.h>
#include <cstdio>
#include <cstdint>

#define LAS __attribute__((address_space(3)))
#define GAS __attribute__((address_space(1)))
typedef unsigned short bf16_t;
typedef short bf16x8 __attribute__((ext_vector_type(8)));
typedef short s16x4 __attribute__((ext_vector_type(4)));
typedef float f32x4 __attribute__((ext_vector_type(4)));
typedef float f32x16 __attribute__((ext_vector_type(16)));
typedef unsigned u32x4 __attribute__((ext_vector_type(4)));
typedef unsigned u32x2 __attribute__((ext_vector_type(2)));
typedef float f32x2_t __attribute__((ext_vector_type(2)));
typedef __bf16 bf16x2_t __attribute__((ext_vector_type(2)));
typedef short v4i16_t __attribute__((ext_vector_type(4)));

#ifndef MK_PER_PHASE
#define MK_PER_PHASE 0
#endif

constexpr int DM = 1024, MROWS = 8192, MPROMPT = 4096, KROWS = 8704, NIN = 6304, NINP = 6400, DFF = 4096;
constexpr float EPSF = 1e-6f;
constexpr float LOG2E = 1.4426950408889634f;
constexpr size_t OUT_Y = 0, OUT_DK = 8388608, OUT_DV = 12582912, OUT_CKV = 16777216, OUT_KPE = 18874368;

constexpr size_t al256(size_t x) { return (x + 255) & ~(size_t)255; }
constexpr size_t WS_CTL = 0, CTL_ZERO_BYTES = 65536;
constexpr size_t WS_BT1 = 65536;
constexpr size_t WS_BT2A = WS_BT1 + (size_t)NINP * 1024 * 2;
constexpr size_t WS_BT2B = WS_BT2A + (size_t)768 * 384 * 2;
constexpr size_t WS_BT4 = WS_BT2B + (size_t)1024 * 256 * 2;
constexpr size_t WS_BT5 = WS_BT4 + (size_t)1024 * 1536 * 2;
constexpr size_t WS_BT6 = WS_BT5 + (size_t)1024 * 1024 * 2;
constexpr size_t WS_BT7 = WS_BT6 + (size_t)4096 * 1024 * 2;
constexpr size_t WS_MOD = WS_BT7 + (size_t)1024 * 4096 * 2;
constexpr size_t WS_BIAS1 = WS_MOD + al256(2 * 3 * 6144 * 4);
constexpr size_t WS_BIAS2 = WS_BIAS1 + al256(2 * 3 * NIN * 4);
constexpr size_t WS_TAB = WS_BIAS2 + al256(2 * 3 * 4096 * 4);
constexpr size_t WS_XN = WS_TAB + 16384;
constexpr size_t WS_XSS = WS_XN + (size_t)MROWS * 1024 * 2;
constexpr size_t WS_U = WS_XSS + (size_t)MROWS * 16 * 4;
constexpr size_t WS_QD = WS_U + (size_t)MROWS * 512 * 2;
constexpr size_t WS_KD = WS_QD + (size_t)MROWS * 512 * 2;
constexpr size_t WS_VD = WS_KD + (size_t)KROWS * 512 * 2;
constexpr size_t WS_CQ = WS_VD + (size_t)KROWS * 512 * 2;
constexpr size_t WS_CQP = WS_CQ + (size_t)MROWS * 384 * 2;
constexpr size_t WS_CKVA = WS_CQP + (size_t)MROWS * 8 * 4;
constexpr size_t WS_CKVP = WS_CKVA + (size_t)KROWS * 256 * 2;
constexpr size_t WS_KPER = WS_CKVP + (size_t)MROWS * 4 * 4;
constexpr size_t WS_KPESS = WS_KPER + (size_t)KROWS * 32 * 4;
constexpr size_t WS_QM = WS_KPESS + al256(KROWS * 4);
constexpr size_t WS_QSS = WS_QM + (size_t)MROWS * 768 * 2;
constexpr size_t WS_KM = WS_QSS + (size_t)MROWS * 24 * 4;
constexpr size_t WS_VM = WS_KM + (size_t)KROWS * 768 * 2;
constexpr size_t WS_ACAT = WS_VM + (size_t)KROWS * 512 * 2;
constexpr size_t WS_MG = WS_ACAT + (size_t)MROWS * 1536 * 2;
constexpr size_t WS_R1 = WS_MG + (size_t)MROWS * 1024 * 2;
constexpr size_t WS_BT4B = WS_R1 + (size_t)MROWS * 4096 * 2;
constexpr size_t WS_BT5B = WS_BT4B + (size_t)1024 * 1536 * 2;
constexpr size_t WS_BT6B = WS_BT5B + (size_t)1024 * 1024 * 2;
constexpr size_t WS_BT7B = WS_BT6B + (size_t)4096 * 1024 * 2;
constexpr size_t WS_END = WS_BT7B + (size_t)1024 * 4096 * 2;
static_assert(WS_END <= 268435456, "d_ws map exceeds 256 MiB");
static_assert(WS_QM + 67108864 <= WS_R1, "split-K slab must end before the G/H region");

constexpr int RING_BYTES = 131072, LDSCTL_OFF = RING_BYTES, LDS_BYTES = 147456;

__device__ __forceinline__ unsigned pk2(float lo, float hi) { f32x2_t v = {lo, hi}; bf16x2_t b = __builtin_convertvector(v, bf16x2_t); return __builtin_bit_cast(unsigned, b); }
__device__ __forceinline__ float bflo(unsigned w) { return __uint_as_float(w << 16); }
__device__ __forceinline__ float bfhi(unsigned w) { return __uint_as_float(w & 0xffff0000u); }
__device__ __forceinline__ float sigmoidf_(float x) { return __builtin_amdgcn_rcpf(1.0f + __expf(-x)); }
__device__ __forceinline__ float wave_sum(float v) {
#pragma unroll
    for (int o = 1; o < 64; o <<= 1) v += __shfl_xor(v, o);
    return v;
}
__device__ __forceinline__ float sum4(f32x4 a) { return (a[0] + a[1]) + (a[2] + a[3]); }
__device__ __forceinline__ float rinv16(const float* p, float invn) {
    const f32x4 a = ((const f32x4*)p)[0], b = ((const f32x4*)p)[1], c = ((const f32x4*)p)[2], d = ((const f32x4*)p)[3];
    return rsqrtf(((sum4(a) + sum4(b)) + (sum4(c) + sum4(d))) * invn + EPSF);
}
__device__ __forceinline__ void rinv8(const float* xss, int rbase, int fq, float (&ri)[8]) {
    f32x4 p[8];
#pragma unroll
    for (int j = 0; j < 8; ++j) p[j] = *(const f32x4*)(xss + (size_t)(rbase + (j >> 2) * 128 + (j & 3) * 16) * 16 + 4 * fq);
#pragma unroll
    for (int j = 0; j < 8; ++j) { float sacc = sum4(p[j]); sacc += __shfl_xor(sacc, 16); sacc += __shfl_xor(sacc, 32); ri[j] = rsqrtf(sacc * (1.0f / 1024.0f) + EPSF); }
}
__device__ __forceinline__ int keyrow(int row) {
    return row < 4096 ? row : (row < 8192 ? row + 256 * (((row - 4096) >> 11) + 1) : 4096 + ((row - 8192) >> 8) * 2304 + ((row - 8192) & 255));
}
__device__ __forceinline__ int crow(int r, int hi) { return (r & 3) + 8 * (r >> 2) + 4 * hi; }
__device__ __forceinline__ u32x4 gld16(const void* p) { return *(const GAS u32x4*)(unsigned long long)(uintptr_t)p; }
__device__ __forceinline__ f32x4 gldf4(const void* p) { return *(const GAS f32x4*)(unsigned long long)(uintptr_t)p; }
#define LDS_WAIT() asm volatile("s_waitcnt lgkmcnt(0)" ::: "memory")
#define MEMFENCE() asm volatile("" ::: "memory")
template <class T> __device__ __forceinline__ T* launder(T* p) { unsigned long long v = (unsigned long long)(uintptr_t)p; asm volatile("" : "+s"(v)); return (T*)(GAS T*)v; }
__device__ __forceinline__ int launder_s(int v) { asm volatile("" : "+s"(v)); return v; }
__device__ __forceinline__ int mk_tid(int wave0) {
    int lane_;
    asm volatile("v_mbcnt_lo_u32_b32 %0, -1, 0\n\tv_mbcnt_hi_u32_b32 %0, -1, %0" : "=v"(lane_));
    return wave0 * 64 + lane_;
}
#define VM_WAIT() asm volatile("s_waitcnt vmcnt(0)" ::: "memory")

namespace pg8 {
constexpr int BM = 256, BK = 64, HALF = 128, HTB = HALF * BK * 2, STAGE_BYTES = 8 * HTB, NXCD = 8, WGM = 8;
__host__ __device__ __forceinline__ int lds_byte(int r, int c) { const int st = (r >> 4) * 2 + (c >> 5), rr = r & 15, cc = c & 31, ob = rr * 64 + cc * 2; return st * 1024 + (ob ^ (((ob >> 9) & 1) << 5)); }
__host__ __device__ __forceinline__ void stage_rc(int b, int& R, int& C) { const int st = b / 1024, sb = b % 1024, swz = sb ^ (((sb >> 9) & 1) << 5); R = (st >> 1) * 16 + swz / 64; C = (st & 1) * 32 + (swz % 64) / 2; }
struct Unit { int pm, pn, ks; };
struct Gemm { const bf16_t* A; const bf16_t* Bt; int M, N, K; };
struct StaticOrder {
    int nM, nN, nwg, G, c, nsplit;
    __host__ __device__ void init(int M, int N, int G_, int c_, int nsplit_ = 1) { nM = M / BM; nN = N / BM; nwg = nM * nN; G = G_; c = c_; nsplit = nsplit_; }
    __host__ __device__ bool next(int i, Unit& u) const {
        const long L0 = (long)i * G + c; if (L0 >= (long)nwg * nsplit) return false;
        long L = L0; u.ks = 0;
        if (nsplit == 2) { u.ks = (int)((L0 >> 3) & 1); L = (L0 & 7) + 8 * (L0 >> 4); }
        int wgid = (int)L; { const int q = nwg / NXCD, r = nwg % NXCD, xcd = wgid % NXCD, off = wgid / NXCD; wgid = (xcd < r ? xcd * (q + 1) : r * (q + 1) + (xcd - r) * q) + off; }
        const int nig = WGM * nN, gid = wgid / nig, fm = gid * WGM, gsz = (nM - fm) < WGM ? (nM - fm) : WGM;
        u.pm = fm + ((wgid % nig) % gsz); u.pn = (wgid % nig) / gsz; return true;
    }
};
template <class Epi, bool ALIGN_EPI>
__device__ __forceinline__ void gemm_phase(LAS unsigned char* lds, const Gemm g, const StaticOrder& S, const Epi& E, int wave0) {
    const int tid = mk_tid(wave0);
    const int wid = __builtin_amdgcn_readfirstlane(tid >> 6), lane = tid & 63, wr = wid >> 2, wc = wid & 3, fr = lane & 15, fq = lane >> 4;
    const int K = g.K, nt = K / BK / S.nsplit;
    const size_t ksoff = (size_t)(K / S.nsplit) * 2;
    unsigned voffA[2];
#pragma unroll
    for (int i = 0; i < 2; ++i) { int R, C; stage_rc(tid * 16 + i * 8192, R, C); voffA[i] = (unsigned)(R * K + C) * 2u; }
    const size_t kstep = (size_t)(BK * 2);
    const size_t hstep = (size_t)HALF * K * 2;
    const size_t tstep = 2 * hstep;
    const unsigned ldsw = (unsigned)wid * 1024u;
    const int aoff = lds_byte(wr * 64 + fr, fq * 8), boff = lds_byte(wc * 32 + fr, fq * 8);
#define PG8_SA(b, h) (((b) * 2 + (h)) * HTB)
#define PG8_SB(b, h) ((4 + (b) * 2 + (h)) * HTB)
#define PG8_STAGE(bufoff, gbase) do { _Pragma("unroll") for (int _i = 0; _i < 2; ++_i) \
        __builtin_amdgcn_global_load_lds((const unsigned*)((const char*)(gbase) + voffA[_i]), (LAS unsigned*)(lds + (bufoff) + ldsw + _i * 8192), 16, 0, 0); } while (0)
#define PG8_LDA(dst, b, h) do { _Pragma("unroll") for (int m = 0; m < 4; ++m) _Pragma("unroll") for (int k = 0; k < 2; ++k) dst[m][k] = *(const LAS bf16x8*)(lds + PG8_SA(b, h) + aoff + m * 2048 + k * 1024); } while (0)
#define PG8_LDB(dst, b, h) do { _Pragma("unroll") for (int n = 0; n < 2; ++n) _Pragma("unroll") for (int k = 0; k < 2; ++k) dst[n][k] = *(const LAS bf16x8*)(lds + PG8_SB(b, h) + boff + n * 2048 + k * 1024); } while (0)
#define PG8_MMA(ai, bj, At, Bt) do { __builtin_amdgcn_s_setprio(1); _Pragma("unroll") for (int m = 0; m < 4; ++m) _Pragma("unroll") for (int n = 0; n < 2; ++n) _Pragma("unroll") for (int k = 0; k < 2; ++k) \
        acc[ai][bj][m][n] = __builtin_amdgcn_mfma_f32_16x16x32_bf16(Bt[n][k], At[m][k], acc[ai][bj][m][n], 0, 0, 0); __builtin_amdgcn_s_setprio(0); } while (0)
#define PG8_WAIT_V(n) asm volatile("s_waitcnt vmcnt(" #n ")" ::: "memory")
#define PG8_WAIT_L(n) asm volatile("s_waitcnt lgkmcnt(" #n ")" ::: "memory")
#define PG8_BAR __builtin_amdgcn_s_barrier()
#define PG8_SCHED __builtin_amdgcn_sched_barrier(0)
    Unit cur, nxt; int ui = 0;
    if (!S.next(0, cur)) return;
    f32x4 acc[2][2][4][2];
#pragma unroll
    for (int a = 0; a < 2; ++a)
#pragma unroll
        for (int b = 0; b < 2; ++b)
#pragma unroll
            for (int m = 0; m < 4; ++m)
#pragma unroll
                for (int n = 0; n < 2; ++n) acc[a][b][m][n] = (f32x4){0.f, 0.f, 0.f, 0.f};
    bf16x8 At[4][2], B0[2][2], B1[2][2];
    const char* cA = (const char*)g.A + (size_t)cur.pm * tstep + cur.ks * ksoff; const char* cB = (const char*)g.Bt + (size_t)cur.pn * tstep + cur.ks * ksoff;
    PG8_STAGE(PG8_SB(0, 0), cB); PG8_STAGE(PG8_SB(0, 1), cB + hstep); PG8_STAGE(PG8_SA(0, 0), cA); PG8_STAGE(PG8_SA(0, 1), cA + hstep);
    if (wr == 1) PG8_BAR;
    PG8_WAIT_V(2); PG8_BAR;
    PG8_STAGE(PG8_SB(1, 0), cB + kstep); PG8_STAGE(PG8_SA(1, 0), cA + kstep); PG8_STAGE(PG8_SB(1, 1), cB + hstep + kstep);
    PG8_WAIT_V(6); PG8_BAR;
    for (;;) {
        const bool has_next = S.next(ui + 1, nxt);
        const char* nA = has_next ? (const char*)g.A + (size_t)nxt.pm * tstep + nxt.ks * ksoff : cA; const char* nB = has_next ? (const char*)g.Bt + (size_t)nxt.pn * tstep + nxt.ks * ksoff : cB;
#pragma unroll 1
        for (int t = 0; t < nt; t += 2) {
            if constexpr (Epi::HOOK) { const int tg = cur.ks * nt + t; if (tg == 8 || tg == 16) E.hook(acc, cur, tg, wr, wc, fr, fq); }
            const bool last = (t == nt - 2);
            const char* a1 = cA + (size_t)(t + 1) * kstep;
            const char* a2 = last ? nA : cA + (size_t)(t + 2) * kstep; const char* b2 = last ? nB : cB + (size_t)(t + 2) * kstep;
            const char* a3 = a2 + kstep; const char* b3 = b2 + kstep;
            PG8_LDB(B0, 0, 0); PG8_LDB(B1, 0, 1); PG8_SCHED; PG8_LDA(At, 0, 0); PG8_STAGE(PG8_SA(1, 1), a1 + hstep);
            PG8_WAIT_V(8); PG8_WAIT_L(0); PG8_BAR; PG8_MMA(0, 0, At, B0); PG8_MMA(0, 1, At, B1); PG8_BAR; PG8_SCHED;
            PG8_LDA(At, 0, 1); PG8_STAGE(PG8_SB(0, 0), b2); PG8_STAGE(PG8_SB(0, 1), b2 + hstep); PG8_STAGE(PG8_SA(0, 0), a2);
            PG8_WAIT_V(8); PG8_WAIT_L(0); PG8_BAR; PG8_MMA(1, 0, At, B0); PG8_MMA(1, 1, At, B1); PG8_BAR; PG8_SCHED;
            PG8_LDB(B0, 1, 0); PG8_LDB(B1, 1, 1); PG8_SCHED; PG8_LDA(At, 1, 0); PG8_STAGE(PG8_SA(0, 1), a2 + hstep);
            PG8_WAIT_V(8); PG8_WAIT_L(0); PG8_BAR; PG8_MMA(0, 0, At, B0); PG8_MMA(0, 1, At, B1); PG8_BAR; PG8_SCHED;
            PG8_LDA(At, 1, 1); PG8_STAGE(PG8_SB(1, 0), b3); PG8_STAGE(PG8_SB(1, 1), b3 + hstep); PG8_STAGE(PG8_SA(1, 0), a3);
            PG8_WAIT_V(8); PG8_WAIT_L(0); PG8_BAR; PG8_MMA(1, 0, At, B0); PG8_MMA(1, 1, At, B1); PG8_BAR; PG8_SCHED;
        }
        if constexpr (ALIGN_EPI) { if (wr == 0) PG8_BAR; }
        if constexpr (Epi::SPLIT) {
            E.pre(acc, cur, S.nsplit, wr, wc, fr, fq);
            bool run_epi = true;
            if (S.nsplit == 2) run_epi = E.exchange(acc, cur.pm * S.nN + cur.pn, cur.ks, wid, lane);
            if (run_epi) E(acc, cur, wr, wc, fr, fq);
        } else E(acc, cur, wr, wc, fr, fq);
        if (!has_next) break;
#pragma unroll
        for (int a = 0; a < 2; ++a)
#pragma unroll
            for (int b = 0; b < 2; ++b)
#pragma unroll
                for (int m = 0; m < 4; ++m)
#pragma unroll
                    for (int n = 0; n < 2; ++n) acc[a][b][m][n] = (f32x4){0.f, 0.f, 0.f, 0.f};
        cur = nxt; cA = nA; cB = nB; ++ui;
        if constexpr (ALIGN_EPI) { if (wr == 1) PG8_BAR; }
    }
    PG8_WAIT_V(0);
    if constexpr (!ALIGN_EPI) { if (wr == 0) PG8_BAR; }
    PG8_BAR;
#undef PG8_SA
#undef PG8_SB
#undef PG8_STAGE
#undef PG8_LDA
#undef PG8_LDB
#undef PG8_MMA
#undef PG8_WAIT_V
#undef PG8_WAIT_L
#undef PG8_BAR
#undef PG8_SCHED
}
}
using pg8::Unit;
typedef f32x4 Acc[2][2][4][2];

#define XCCTAB_WORD 15360
__device__ __forceinline__ bool splitk_exchange(Acc& acc, unsigned char* ws, int cnt_off, int tile, int ks, int wid, int lane) {
    unsigned* ctl = (unsigned*)(ws + WS_CTL);
    const __amdgpu_buffer_rsrc_t rsrc = __builtin_amdgcn_make_buffer_rsrc((void*)(ws + WS_QM), 0, 67108864, 0x00020000);
    const unsigned base = (unsigned)(((ks * 128 + tile) * 8 + wid) * 32) * 1024u + (unsigned)lane * 16u;
    const unsigned obase = (unsigned)((((ks ^ 1) * 128 + tile) * 8 + wid) * 32) * 1024u + (unsigned)lane * 16u;
    const unsigned mine = __hip_atomic_load(ctl + XCCTAB_WORD + blockIdx.x, __ATOMIC_RELAXED, __HIP_MEMORY_SCOPE_AGENT);
    const unsigned theirs = __hip_atomic_load(ctl + XCCTAB_WORD + (blockIdx.x ^ 8u), __ATOMIC_RELAXED, __HIP_MEMORY_SCOPE_AGENT);
    const bool same = __builtin_amdgcn_readfirstlane((int)(mine == theirs && mine != 0u)) != 0;
    if (same) {
#pragma unroll
        for (int ai = 0; ai < 2; ++ai)
#pragma unroll
            for (int bj = 0; bj < 2; ++bj)
#pragma unroll
                for (int m = 0; m < 4; ++m)
#pragma unroll
                    for (int n = 0; n < 2; ++n) { const int q = ((ai * 2 + bj) * 4 + m) * 2 + n; __builtin_amdgcn_raw_buffer_store_b128(__builtin_bit_cast(u32x4, acc[ai][bj][m][n]), rsrc, base + q * 1024, 0, 0); }
    } else {
#pragma unroll
        for (int ai = 0; ai < 2; ++ai)
#pragma unroll
            for (int bj = 0; bj < 2; ++bj)
#pragma unroll
                for (int m = 0; m < 4; ++m)
#pragma unroll
                    for (int n = 0; n < 2; ++n) { const int q = ((ai * 2 + bj) * 4 + m) * 2 + n; __builtin_amdgcn_raw_buffer_store_b128(__builtin_bit_cast(u32x4, acc[ai][bj][m][n]), rsrc, base + q * 1024, 0, 16); }
    }
    asm volatile("s_waitcnt vmcnt(0)" ::: "memory");
    unsigned ticket = 0;
    if (lane == 0) ticket = __hip_atomic_fetch_add(ctl + cnt_off + tile * 8 + wid, 1u, __ATOMIC_RELAXED, __HIP_MEMORY_SCOPE_AGENT);
    ticket = (unsigned)__builtin_amdgcn_readfirstlane((int)ticket);
    if (ticket == 0u) return false;
#pragma unroll
    for (int ai = 0; ai < 2; ++ai) {
        u32x4 v[2][4][2];
#pragma unroll
        for (int bj = 0; bj < 2; ++bj)
#pragma unroll
            for (int m = 0; m < 4; ++m)
#pragma unroll
                for (int n = 0; n < 2; ++n) { const int q = ((ai * 2 + bj) * 4 + m) * 2 + n; v[bj][m][n] = __builtin_amdgcn_raw_buffer_load_b128(rsrc, obase + q * 1024, 0, 16); }
#pragma unroll
        for (int bj = 0; bj < 2; ++bj)
#pragma unroll
            for (int m = 0; m < 4; ++m)
#pragma unroll
                for (int n = 0; n < 2; ++n) { f32x4& d = acc[ai][bj][m][n]; const u32x4 x = v[bj][m][n];
                    d[0] += __uint_as_float(x.x); d[1] += __uint_as_float(x.y); d[2] += __uint_as_float(x.z); d[3] += __uint_as_float(x.w); }
        asm volatile("" : "+v"(acc[ai][0][0][0]), "+v"(acc[ai][0][0][1]), "+v"(acc[ai][0][1][0]), "+v"(acc[ai][0][1][1]), "+v"(acc[ai][0][2][0]), "+v"(acc[ai][0][2][1]), "+v"(acc[ai][0][3][0]), "+v"(acc[ai][0][3][1]),
                          "+v"(acc[ai][1][0][0]), "+v"(acc[ai][1][0][1]), "+v"(acc[ai][1][1][0]), "+v"(acc[ai][1][1][1]), "+v"(acc[ai][1][2][0]), "+v"(acc[ai][1][2][1]), "+v"(acc[ai][1][3][0]), "+v"(acc[ai][1][3][1]) :: "memory");
    }
    return true;
}


struct EpiIn {
    static constexpr bool HOOK = false, SPLIT = false;
    unsigned char* ws0; float* out0; const float* gq; const float* gk; int layer; int pn_off;
    __device__ __forceinline__ void hook(Acc&, const Unit&, int, int, int, int, int) const {}
    __device__ __forceinline__ void operator()(const Acc& acc, const Unit& u, int wr, int wc, int fr, int fq) const {
        unsigned char* ws = launder(ws0); float* out = launder(out0);
        const float* xss = (const float*)(ws + WS_XSS); const float* bias = (const float*)(ws + WS_BIAS1) + (size_t)layer * 3 * NIN;
        const float* cosD = (const float*)(ws + WS_TAB); const float* sinD = cosD + 1024;
        bf16_t* U = (bf16_t*)(ws + WS_U); bf16_t* QD = (bf16_t*)(ws + WS_QD); bf16_t* KD = (bf16_t*)(ws + WS_KD); bf16_t* VD = (bf16_t*)(ws + WS_VD);
        bf16_t* CQ = (bf16_t*)(ws + WS_CQ); bf16_t* CKVA = (bf16_t*)(ws + WS_CKVA); bf16_t* G = (bf16_t*)(ws + WS_R1);
        float* cqpart = (float*)(ws + WS_CQP); float* ckvpart = (float*)(ws + WS_CKVP); float* kperaw = (float*)(ws + WS_KPER); float* kpess = (float*)(ws + WS_KPESS);
        const int pm = u.pm, pn = u.pn + pn_off;
        const int cond = pm < 16 ? 0 : 1 + ((pm - 16) >> 3);
        const bool sample = pm >= 16;
        const int rbase = pm * 256 + wr * 64 + fr;
        const float* bs = bias + cond * NIN;
        float ri8[8]; rinv8(xss, rbase, fq, ri8);
        if (pn < 4) {
            const int ch0 = 128 * pn + 32 * wc + 8 * fq;
            f32x4 ba[2], bg[2];
#pragma unroll
            for (int n = 0; n < 2; ++n) { ba[n] = *(const f32x4*)(bs + ch0 + 4 * n); bg[n] = *(const f32x4*)(bs + 512 + ch0 + 4 * n); }
#pragma unroll
            for (int ai = 0; ai < 2; ++ai)
#pragma unroll
                for (int m = 0; m < 4; ++m) {
                    const int row = rbase + ai * 128 + m * 16; const float ri = ri8[ai * 4 + m];
                    float o[8];
#pragma unroll
                    for (int n = 0; n < 2; ++n)
#pragma unroll
                        for (int i = 0; i < 4; ++i) { const float a = ri * acc[ai][0][m][n][i] + ba[n][i], gte = ri * acc[ai][1][m][n][i] + bg[n][i]; o[4 * n + i] = a * sigmoidf_(gte); }
                    u32x4 w; w.x = pk2(o[0], o[1]); w.y = pk2(o[2], o[3]); w.z = pk2(o[4], o[5]); w.w = pk2(o[6], o[7]);
                    *(u32x4*)(U + (size_t)row * 512 + ch0) = w;
                }
        } else if (pn < 8) {
            const bool isk = pn >= 6; const int grp = 4 * ((pn - 4) & 1) + wc;
            const int ob = (isk ? 1536 : 1024) + 64 * grp; const float* gv = isk ? gk : gq;
            f32x4 bq[2][2];
#pragma unroll
            for (int bj = 0; bj < 2; ++bj)
#pragma unroll
                for (int n = 0; n < 2; ++n) bq[bj][n] = *(const f32x4*)(bs + ob + 32 * bj + 16 * n + 4 * fq);
#pragma unroll
            for (int ai = 0; ai < 2; ++ai)
#pragma unroll
                for (int m = 0; m < 4; ++m) {
                    const int row = rbase + ai * 128 + m * 16; const float ri = ri8[ai * 4 + m];
                    f32x4 v[2][2]; float ss = 0.f;
#pragma unroll
                    for (int bj = 0; bj < 2; ++bj)
#pragma unroll
                        for (int n = 0; n < 2; ++n) { v[bj][n] = acc[ai][bj][m][n] * ri + bq[bj][n]; const f32x4 q2 = v[bj][n] * v[bj][n]; ss += sum4(q2); }
                    ss += __shfl_xor(ss, 16); ss += __shfl_xor(ss, 32);
                    const float rn = rsqrtf(ss * (1.0f / 64.0f) + EPSF);
#pragma unroll
                    for (int bj = 0; bj < 2; ++bj)
#pragma unroll
                        for (int n = 0; n < 2; ++n) v[bj][n] = v[bj][n] * rn * *(const f32x4*)(gv + 32 * bj + 16 * n + 4 * fq);
                    if (isk && !sample) {
                        float* op = out + OUT_DK + ((size_t)(pm * 2 + layer) * 256 + (row & 255)) * 512 + 64 * grp + 4 * fq;
#pragma unroll
                        for (int bj = 0; bj < 2; ++bj)
#pragma unroll
                            for (int n = 0; n < 2; ++n) *(f32x4*)(op + 32 * bj + 16 * n) = v[bj][n];
                    }
                    if (sample) {
                        const int s = row & 2047;
#pragma unroll
                        for (int bj = 0; bj < 2; ++bj) {
                            const int pos = bj == 0 ? (s >> 6) : (s & 63);
                            const f32x4 c4 = *(const f32x4*)(cosD + pos * 16 + 4 * fq), s4 = *(const f32x4*)(sinD + pos * 16 + 4 * fq);
                            const f32x4 x1 = v[bj][0], x2 = v[bj][1];
                            v[bj][0] = x1 * c4 - x2 * s4; v[bj][1] = x2 * c4 + x1 * s4;
                        }
                    }
                    const float qs = isk ? 1.0f : 0.125f * LOG2E;
                    bf16_t* dp = (isk ? KD + (size_t)keyrow(row) * 512 : QD + (size_t)row * 512) + 64 * grp + 4 * fq;
#pragma unroll
                    for (int bj = 0; bj < 2; ++bj)
#pragma unroll
                        for (int n = 0; n < 2; ++n) { const f32x4 x = v[bj][n] * qs; u32x2 w; w.x = pk2(x[0], x[1]); w.y = pk2(x[2], x[3]); *(u32x2*)(dp + 32 * bj + 16 * n) = w; }
                    MEMFENCE();
                }
        } else {
            int obase, kind;
            if (pn < 10) { kind = 0; obase = 2048 + 256 * (pn - 8); }
            else if (pn == 10) { kind = 1; obase = 2560; }
            else if (pn == 11) { kind = 2; obase = 2816; }
            else if (pn == 12) { kind = 3; obase = 2944; }
            else { kind = 4; obase = 3232 + 256 * (pn - 13); }
            const int lc0 = 32 * wc + 8 * fq;
            f32x4 gb0[2], gb1[2];
#pragma unroll
            for (int bj = 0; bj < 2; ++bj) { int oc = obase + 128 * bj + lc0; if (kind == 2 && bj == 1) oc = 3200 + 8 * fq; gb0[bj] = *(const f32x4*)(bs + oc); gb1[bj] = *(const f32x4*)(bs + oc + 4); }
#pragma unroll
            for (int ai = 0; ai < 2; ++ai)
#pragma unroll
                for (int m = 0; m < 4; ++m) {
                    const int row = rbase + ai * 128 + m * 16; const float ri = ri8[ai * 4 + m];
                    float ssw = 0.f;
#pragma unroll
                    for (int bj = 0; bj < 2; ++bj) {
                        int oc = obase + 128 * bj + lc0;
                        bool live = true;
                        if (kind == 2 && bj == 1) { oc = 3200 + 8 * fq; live = (wc == 0); }
                        float o[8];
                        if (live) {
                            const f32x4 b0 = gb0[bj], b1 = gb1[bj];
#pragma unroll
                            for (int i = 0; i < 4; ++i) { o[i] = ri * acc[ai][bj][m][0][i] + b0[i]; o[4 + i] = ri * acc[ai][bj][m][1][i] + b1[i]; }
                        } else {
#pragma unroll
                            for (int i = 0; i < 8; ++i) o[i] = 0.f;
                        }
                        float ssl = 0.f;
#pragma unroll
                        for (int i = 0; i < 8; ++i) ssl += o[i] * o[i];
                        const int lc = 128 * bj + lc0;
                        if (kind == 0) {
                            const int col = 256 * (pn - 8) + lc;
                            u32x4 w; w.x = pk2(o[0], o[1]); w.y = pk2(o[2], o[3]); w.z = pk2(o[4], o[5]); w.w = pk2(o[6], o[7]);
                            *(u32x4*)(VD + (size_t)keyrow(row) * 512 + col) = w;
                            if (!sample) { float* op = out + OUT_DV + ((size_t)(pm * 2 + layer) * 256 + (row & 255)) * 512 + col;
                                *(f32x4*)op = (f32x4){o[0], o[1], o[2], o[3]}; *(f32x4*)(op + 4) = (f32x4){o[4], o[5], o[6], o[7]}; }
                        } else if (kind == 1 || (kind == 2 && bj == 0)) {
                            const int col = (kind == 1 ? 0 : 256) + lc;
                            u32x4 w; w.x = pk2(o[0], o[1]); w.y = pk2(o[2], o[3]); w.z = pk2(o[4], o[5]); w.w = pk2(o[6], o[7]);
                            *(u32x4*)(CQ + (size_t)row * 384 + col) = w; ssw += ssl;
                        } else if (kind == 2) {
                            float st = ssl; st += __shfl_xor(st, 16); st += __shfl_xor(st, 32);
                            if (live) {
                                float* kp = kperaw + (size_t)row * 32 + 8 * fq;
                                *(f32x4*)kp = (f32x4){o[0], o[1], o[2], o[3]}; *(f32x4*)(kp + 4) = (f32x4){o[4], o[5], o[6], o[7]};
                                if (fq == 0) kpess[row] = st;
                                if (!sample) { float* op = out + OUT_KPE + ((size_t)(pm * 2 + layer) * 256 + (row & 255)) * 32 + 8 * fq;
                                    *(f32x4*)op = (f32x4){o[0], o[1], o[2], o[3]}; *(f32x4*)(op + 4) = (f32x4){o[4], o[5], o[6], o[7]}; }
                            }
                        } else if (kind == 3) {
                            u32x4 w; w.x = pk2(o[0], o[1]); w.y = pk2(o[2], o[3]); w.z = pk2(o[4], o[5]); w.w = pk2(o[6], o[7]);
                            *(u32x4*)(CKVA + (size_t)row * 256 + lc) = w; ssw += ssl;
                            if (!sample) { float* op = out + OUT_CKV + ((size_t)(pm * 2 + layer) * 256 + (row & 255)) * 256 + lc;
                                *(f32x4*)op = (f32x4){o[0], o[1], o[2], o[3]}; *(f32x4*)(op + 4) = (f32x4){o[4], o[5], o[6], o[7]}; }
                        } else {
                            const int col = 256 * (pn - 13) + lc;
                            u32x4 w; w.x = pk2(sigmoidf_(o[0]), sigmoidf_(o[1])); w.y = pk2(sigmoidf_(o[2]), sigmoidf_(o[3])); w.z = pk2(sigmoidf_(o[4]), sigmoidf_(o[5])); w.w = pk2(sigmoidf_(o[6]), sigmoidf_(o[7]));
                            *(u32x4*)(G + (size_t)row * 3072 + col) = w;
                        }
                    }
                    if (kind == 1 || kind == 2 || kind == 3) {
                        ssw += __shfl_xor(ssw, 16); ssw += __shfl_xor(ssw, 32);
                        if (fq == 0) { if (kind == 1) cqpart[(size_t)row * 8 + wc] = ssw; else if (kind == 2) cqpart[(size_t)row * 8 + 4 + wc] = ssw; else ckvpart[(size_t)row * 4 + wc] = ssw; }
                    }
                }
        }
    }
};

struct EpiQM {
    static constexpr bool HOOK = false, SPLIT = false;
    unsigned char* ws0; const float* gqm;
    __device__ __forceinline__ void hook(Acc&, const Unit&, int, int, int, int, int) const {}
    __device__ __forceinline__ void operator()(const Acc& acc, const Unit& u, int wr, int wc, int fr, int fq) const {
        unsigned char* ws = launder(ws0);
        const float* cosM = (const float*)(ws + WS_TAB) + 2048; const float* sinM = cosM + 512; bf16_t* QM = (bf16_t*)(ws + WS_QM); float* qss = (float*)(ws + WS_QSS);
        const int pm = u.pm, pn = u.pn; const bool sample = pm >= 16; const int rbase = pm * 256 + wr * 64 + fr;
#pragma unroll
        for (int bj = 0; bj < 2; ++bj) {
            const int blk = 8 * pn + 4 * bj + wc, h = blk / 3, part = blk - 3 * h;
            int d0, d1;
            if (part < 2) { d0 = 32 * part + 4 * fq; d1 = d0 + 16; } else { d0 = 64 + 16 * (fq >> 1) + 4 * (fq & 1); d1 = d0 + 8; }
            const f32x4 g0 = *(const f32x4*)(gqm + d0), g1 = *(const f32x4*)(gqm + d1);
#pragma unroll
            for (int ai = 0; ai < 2; ++ai)
#pragma unroll
                for (int m = 0; m < 4; ++m) {
                    const int row = rbase + ai * 128 + m * 16;
                    const f32x4 z0 = acc[ai][bj][m][0], z1 = acc[ai][bj][m][1];
                    float ss = sum4(z0 * z0) + sum4(z1 * z1); ss += __shfl_xor(ss, 16); ss += __shfl_xor(ss, 32);
                    if (fq == 0) qss[(size_t)row * 24 + blk] = ss;
                    f32x4 y0 = z0 * g0, y1 = z1 * g1;
                    if (part == 2 && sample) {
                        const int s = row & 2047, pos = (fq >> 1) == 0 ? (s >> 6) : (s & 63);
                        const f32x4 c4 = *(const f32x4*)(cosM + pos * 8 + 4 * (fq & 1)), s4 = *(const f32x4*)(sinM + pos * 8 + 4 * (fq & 1));
                        const f32x4 x1 = y0, x2 = y1; y0 = x1 * c4 - x2 * s4; y1 = x2 * c4 + x1 * s4;
                    }
                    bf16_t* dp = QM + (size_t)row * 768 + 96 * h;
                    u32x2 w0, w1; w0.x = pk2(y0[0], y0[1]); w0.y = pk2(y0[2], y0[3]); w1.x = pk2(y1[0], y1[1]); w1.y = pk2(y1[2], y1[3]);
                    *(u32x2*)(dp + d0) = w0; *(u32x2*)(dp + d1) = w1;
                    MEMFENCE();
                }
        }
    }
};

struct EpiKV {
    static constexpr bool HOOK = false, SPLIT = false;
    unsigned char* ws0; float* out0; const float* gkm; const float* gkva; int layer;
    __device__ __forceinline__ void hook(Acc&, const Unit&, int, int, int, int, int) const {}
    __device__ __forceinline__ void operator()(const Acc& acc, const Unit& u, int wr, int wc, int fr, int fq) const {
        unsigned char* ws = launder(ws0); float* out = launder(out0);
        const float* ckvpart = (const float*)(ws + WS_CKVP); const float* kpess = (const float*)(ws + WS_KPESS); const float* kperaw = (const float*)(ws + WS_KPER);
        const float* cosM = (const float*)(ws + WS_TAB) + 2048; const float* sinM = cosM + 512; bf16_t* KM = (bf16_t*)(ws + WS_KM); bf16_t* VM = (bf16_t*)(ws + WS_VM);
        const int pm = u.pm, pn = u.pn; const int rbase = pm * 256 + wr * 64 + fr;
        const bool newtok = pm < 32, rope = pm >= 16 && pm < 32;
#pragma unroll
        for (int ai = 0; ai < 2; ++ai)
#pragma unroll
            for (int m = 0; m < 4; ++m) {
                const int row = rbase + ai * 128 + m * 16; const int kr = keyrow(row);
                float rc = 1.0f;
                if (newtok) { const f32x4 p = *(const f32x4*)(ckvpart + (size_t)row * 4); rc = rsqrtf(sum4(p) * (1.0f / 256.0f) + EPSF); }
                if (pn < 2) {
                    const int h = 4 * pn + wc;
                    f32x4 v[2][2]; float ss = 0.f;
#pragma unroll
                    for (int bj = 0; bj < 2; ++bj)
#pragma unroll
                        for (int n = 0; n < 2; ++n) { v[bj][n] = acc[ai][bj][m][n] * rc; ss += sum4(v[bj][n] * v[bj][n]); }
                    ss += __shfl_xor(ss, 16); ss += __shfl_xor(ss, 32);
                    ss += kpess[row];
                    const float rk = rsqrtf(ss * (1.0f / 96.0f) + EPSF);
                    bf16_t* dp = KM + (size_t)kr * 768 + 96 * h;
#pragma unroll
                    for (int bj = 0; bj < 2; ++bj)
#pragma unroll
                        for (int n = 0; n < 2; ++n) { const int d = 32 * bj + 16 * n + 4 * fq; const f32x4 x = v[bj][n] * rk * *(const f32x4*)(gkm + d);
                            u32x2 w; w.x = pk2(x[0], x[1]); w.y = pk2(x[2], x[3]); *(u32x2*)(dp + d) = w; }
                    const int e0 = 16 * (fq >> 1) + 4 * (fq & 1);
                    f32x4 x1 = *(const f32x4*)(kperaw + (size_t)row * 32 + e0) * rk * *(const f32x4*)(gkm + 64 + e0);
                    f32x4 x2 = *(const f32x4*)(kperaw + (size_t)row * 32 + e0 + 8) * rk * *(const f32x4*)(gkm + 64 + e0 + 8);
                    if (rope) {
                        const int s = row & 2047, pos = (fq >> 1) == 0 ? (s >> 6) : (s & 63);
                        const f32x4 c4 = *(const f32x4*)(cosM + pos * 8 + 4 * (fq & 1)), s4 = *(const f32x4*)(sinM + pos * 8 + 4 * (fq & 1));
                        const f32x4 a = x1, b = x2; x1 = a * c4 - b * s4; x2 = b * c4 + a * s4;
                    }
                    u32x2 w0, w1; w0.x = pk2(x1[0], x1[1]); w0.y = pk2(x1[2], x1[3]); w1.x = pk2(x2[0], x2[1]); w1.y = pk2(x2[2], x2[3]);
                    *(u32x2*)(dp + 64 + e0) = w0; *(u32x2*)(dp + 64 + e0 + 8) = w1;
                } else {
#pragma unroll
                    for (int bj = 0; bj < 2; ++bj) {
                        const int lc = 256 * (pn - 2) + 128 * bj + 32 * wc + 8 * fq;
                        const f32x4 a = acc[ai][bj][m][0] * rc, b = acc[ai][bj][m][1] * rc;
                        u32x4 w; w.x = pk2(a[0], a[1]); w.y = pk2(a[2], a[3]); w.z = pk2(b[0], b[1]); w.w = pk2(b[2], b[3]);
                        *(u32x4*)(VM + (size_t)kr * 512 + lc) = w;
                    }
                    if (pn == 2 && pm < 16) {
                        float* op = out + OUT_CKV + ((size_t)(pm * 2 + layer) * 256 + (row & 255)) * 256 + 64 * wc + 4 * fq;
#pragma unroll
                        for (int t = 0; t < 4; ++t) { f32x4 x = *(f32x4*)(op + 16 * t); x = x * rc * *(const f32x4*)(gkva + 64 * wc + 4 * fq + 16 * t); *(f32x4*)(op + 16 * t) = x; }
                    }
                }
                MEMFENCE();
            }
    }
};

struct EpiMerge {
    static constexpr bool HOOK = true, SPLIT = true;
    unsigned char* ws0; int cnt_off;
    __device__ __forceinline__ void hook(Acc& acc, const Unit& u, int t, int wr, int wc, int fr, int fq) const {
        unsigned char* ws = launder(ws0); const bf16_t* G = (const bf16_t*)(ws + WS_R1);
        const int seg = (t == 8) ? 0 : 1; int rbase = u.pm * 256 + wr * 64 + fr; asm volatile("" : "+v"(rbase));
#pragma unroll
        for (int ai = 0; ai < 2; ++ai) {
            u32x4 ga[4][2], gb[4][2];
#pragma unroll
            for (int m = 0; m < 4; ++m)
#pragma unroll
                for (int bj = 0; bj < 2; ++bj) { const bf16_t* gp = G + (size_t)(rbase + ai * 128 + m * 16) * 3072 + seg * 1024 + 256 * u.pn + 128 * bj + 32 * wc + 8 * fq;
                    ga[m][bj] = *(const u32x4*)gp; gb[m][bj] = *(const u32x4*)(gp + 1024); }
#pragma unroll
            for (int m = 0; m < 4; ++m)
#pragma unroll
                for (int bj = 0; bj < 2; ++bj) { const u32x4 a4 = ga[m][bj], b4 = gb[m][bj];
                    acc[ai][bj][m][0][0] *= bflo(a4.x) * __builtin_amdgcn_rcpf(bflo(b4.x)); acc[ai][bj][m][0][1] *= bfhi(a4.x) * __builtin_amdgcn_rcpf(bfhi(b4.x));
                    acc[ai][bj][m][0][2] *= bflo(a4.y) * __builtin_amdgcn_rcpf(bflo(b4.y)); acc[ai][bj][m][0][3] *= bfhi(a4.y) * __builtin_amdgcn_rcpf(bfhi(b4.y));
                    acc[ai][bj][m][1][0] *= bflo(a4.z) * __builtin_amdgcn_rcpf(bflo(b4.z)); acc[ai][bj][m][1][1] *= bfhi(a4.z) * __builtin_amdgcn_rcpf(bfhi(b4.z));
                    acc[ai][bj][m][1][2] *= bflo(a4.w) * __builtin_amdgcn_rcpf(bflo(b4.w)); acc[ai][bj][m][1][3] *= bfhi(a4.w) * __builtin_amdgcn_rcpf(bfhi(b4.w)); }
            MEMFENCE();
        }
    }
    __device__ __forceinline__ void pre(Acc& acc, const Unit& u, int nsplit, int wr, int wc, int fr, int fq) const {
        unsigned char* ws = launder(ws0); const bf16_t* G = (const bf16_t*)(ws + WS_R1);
        const int gsel = (nsplit == 2 && u.ks == 0) ? 1 : 2; const int rbase = u.pm * 256 + wr * 64 + fr;
#pragma unroll
        for (int ai = 0; ai < 2; ++ai) {
            u32x4 gg[4][2];
#pragma unroll
            for (int m = 0; m < 4; ++m)
#pragma unroll
                for (int bj = 0; bj < 2; ++bj) gg[m][bj] = *(const u32x4*)(G + (size_t)(rbase + ai * 128 + m * 16) * 3072 + gsel * 1024 + 256 * u.pn + 128 * bj + 32 * wc + 8 * fq);
#pragma unroll
            for (int m = 0; m < 4; ++m)
#pragma unroll
                for (int bj = 0; bj < 2; ++bj) { const u32x4 g = gg[m][bj];
                    acc[ai][bj][m][0][0] *= bflo(g.x); acc[ai][bj][m][0][1] *= bfhi(g.x); acc[ai][bj][m][0][2] *= bflo(g.y); acc[ai][bj][m][0][3] *= bfhi(g.y);
                    acc[ai][bj][m][1][0] *= bflo(g.z); acc[ai][bj][m][1][1] *= bfhi(g.z); acc[ai][bj][m][1][2] *= bflo(g.w); acc[ai][bj][m][1][3] *= bfhi(g.w); }
            MEMFENCE();
        }
    }
    __device__ __forceinline__ bool exchange(Acc& acc, int tile, int ks, int wid, int lane) const { unsigned char* ws = launder(ws0); return splitk_exchange(acc, ws, cnt_off, tile, ks, wid, lane); }
    __device__ __forceinline__ void operator()(const Acc& acc, const Unit& u, int wr, int wc, int fr, int fq) const {
        unsigned char* ws = launder(ws0); bf16_t* MG = (bf16_t*)(ws + WS_MG);
        const int rbase = u.pm * 256 + wr * 64 + fr;
#pragma unroll
        for (int ai = 0; ai < 2; ++ai)
#pragma unroll
            for (int m = 0; m < 4; ++m) {
                const int row = rbase + ai * 128 + m * 16;
#pragma unroll
                for (int bj = 0; bj < 2; ++bj) {
                    const int col = 256 * u.pn + 128 * bj + 32 * wc + 8 * fq;
                    const f32x4 a = acc[ai][bj][m][0], b = acc[ai][bj][m][1];
                    u32x4 w; w.x = pk2(a[0], a[1]); w.y = pk2(a[2], a[3]); w.z = pk2(b[0], b[1]); w.w = pk2(b[2], b[3]);
                    *(u32x4*)(MG + (size_t)row * 1024 + col) = w;
                }
            }
    }
};

struct EpiRes {
    static constexpr bool HOOK = false, SPLIT = true;
    const float* base_p; const float* base_s;
    float* out0;
    unsigned char* ws0; int gate_off;
    const float* cs_g; int cs_off;
    int cnt_off;
    __device__ __forceinline__ void hook(Acc&, const Unit&, int, int, int, int, int) const {}
    __device__ __forceinline__ void pre(Acc&, const Unit&, int, int, int, int, int) const {}
    __device__ __forceinline__ bool exchange(Acc& acc, int tile, int ks, int wid, int lane) const { unsigned char* ws = launder(ws0); return splitk_exchange(acc, ws, cnt_off, tile, ks, wid, lane); }
    __device__ __forceinline__ void operator()(const Acc& acc, const Unit& u, int wr, int wc, int fr, int fq) const {
        unsigned char* ws = launder(ws0); float* out = launder(out0);
        const float* gate = (const float*)(ws + WS_MOD) + gate_off; const float* cs_sc = (const float*)(ws + WS_MOD) + cs_off; bf16_t* XN = (bf16_t*)(ws + WS_XN); float* xss = (float*)(ws + WS_XSS);
        const int pm = u.pm, pn = u.pn; const int cond = pm < 16 ? 0 : 1 + ((pm - 16) >> 3);
        const int rbase = pm * 256 + wr * 64 + fr;
        const bool nxt = cs_g != nullptr;
        f32x4 gt[2][2], cs[2][2];
#pragma unroll
        for (int bj = 0; bj < 2; ++bj)
#pragma unroll
            for (int n = 0; n < 2; ++n) { const int col = 256 * pn + 128 * bj + 32 * wc + 8 * fq + 4 * n; gt[bj][n] = *(const f32x4*)(gate + cond * 6144 + col);
                if (nxt) cs[bj][n] = *(const f32x4*)(cs_g + col) * (*(const f32x4*)(cs_sc + cond * 6144 + col) + 1.0f); else cs[bj][n] = (f32x4){0.f, 0.f, 0.f, 0.f}; }
#pragma unroll
        for (int aim = 0; aim < 4; ++aim) { const int ai = aim >> 1, m0 = (aim & 1) * 2;
            f32x4 bv[4][2][2];
#pragma unroll
            for (int m = m0; m < m0 + 2; ++m) { const int row = rbase + ai * 128 + m * 16; const float* bp = (row < 4096 ? base_p + (size_t)row * 1024 : base_s + (size_t)(row - 4096) * 1024);
#pragma unroll
                for (int bj = 0; bj < 2; ++bj) { const int col = 256 * pn + 128 * bj + 32 * wc + 8 * fq; bv[m][bj][0] = *(const f32x4*)(bp + col); bv[m][bj][1] = *(const f32x4*)(bp + col + 4); } }
#pragma unroll
            for (int m = m0; m < m0 + 2; ++m) {
                const int row = rbase + ai * 128 + m * 16;
                float ss = 0.f;
#pragma unroll
                for (int bj = 0; bj < 2; ++bj) {
                    const int col = 256 * pn + 128 * bj + 32 * wc + 8 * fq;
                    const f32x4 x0 = bv[m][bj][0] + gt[bj][0] * acc[ai][bj][m][0], x1 = bv[m][bj][1] + gt[bj][1] * acc[ai][bj][m][1];
                    *(f32x4*)(out + (size_t)row * 1024 + col) = x0; *(f32x4*)(out + (size_t)row * 1024 + col + 4) = x1;
                    if (nxt) {
                        ss += sum4(x0 * x0) + sum4(x1 * x1);
                        const f32x4 a = x0 * cs[bj][0], b = x1 * cs[bj][1];
                        u32x4 w; w.x = pk2(a[0], a[1]); w.y = pk2(a[2], a[3]); w.z = pk2(b[0], b[1]); w.w = pk2(b[2], b[3]);
                        *(u32x4*)(XN + (size_t)row * 1024 + col) = w;
                    }
                }
                if (nxt) { ss += __shfl_xor(ss, 16); ss += __shfl_xor(ss, 32); if (fq == 0) xss[(size_t)row * 16 + 4 * pn + wc] = ss; }
            }
            MEMFENCE();
        }
    }
};

struct EpiUp {
    static constexpr bool HOOK = false, SPLIT = false;
    unsigned char* ws0; int layer;
    __device__ __forceinline__ void hook(Acc&, const Unit&, int, int, int, int, int) const {}
    __device__ __forceinline__ void operator()(const Acc& acc, const Unit& u, int wr, int wc, int fr, int fq) const {
        unsigned char* ws = launder(ws0);
        const float* xss = (const float*)(ws + WS_XSS); const float* bias = (const float*)(ws + WS_BIAS2) + (size_t)layer * 3 * 4096; bf16_t* H = (bf16_t*)(ws + WS_R1);
        const int pm = u.pm, pn = u.pn; const int cond = pm < 16 ? 0 : 1 + ((pm - 16) >> 3);
        const int rbase = pm * 256 + wr * 64 + fr;
        f32x4 bv[2][2];
#pragma unroll
        for (int bj = 0; bj < 2; ++bj)
#pragma unroll
            for (int n = 0; n < 2; ++n) bv[bj][n] = *(const f32x4*)(bias + cond * 4096 + 256 * pn + 128 * bj + 32 * wc + 8 * fq + 4 * n);
        float ri8[8]; rinv8(xss, rbase, fq, ri8);
#pragma unroll
        for (int ai = 0; ai < 2; ++ai)
#pragma unroll
            for (int m = 0; m < 4; ++m) {
                const int row = rbase + ai * 128 + m * 16; const float ri = ri8[ai * 4 + m];
#pragma unroll
                for (int bj = 0; bj < 2; ++bj) {
                    const int col = 256 * pn + 128 * bj + 32 * wc + 8 * fq;
                    f32x4 a = acc[ai][bj][m][0] * ri + bv[bj][0], b = acc[ai][bj][m][1] * ri + bv[bj][1];
#pragma unroll
                    for (int i = 0; i < 4; ++i) { a[i] = fmaxf(a[i], 0.f); a[i] *= a[i]; b[i] = fmaxf(b[i], 0.f); b[i] *= b[i]; }
                    u32x4 w; w.x = pk2(a[0], a[1]); w.y = pk2(a[2], a[3]); w.z = pk2(b[0], b[1]); w.w = pk2(b[2], b[3]);
                    *(u32x4*)(H + (size_t)row * 4096 + col) = w;
                }
            }
    }
};

__device__ __forceinline__ s16x4 vtr(const LAS unsigned char* p) { return __builtin_bit_cast(s16x4, __builtin_amdgcn_ds_read_tr16_b64_v4i16((LAS v4i16_t*)p)); }
__device__ __forceinline__ bf16x8 packp(const f32x16& p, int b) {
    u32x4 w; w.x = pk2(p[8 * b + 0], p[8 * b + 1]); w.y = pk2(p[8 * b + 2], p[8 * b + 3]); w.z = pk2(p[8 * b + 4], p[8 * b + 5]); w.w = pk2(p[8 * b + 6], p[8 * b + 7]);
    return __builtin_bit_cast(bf16x8, w);
}
#define MFMA32(a, b, c) __builtin_amdgcn_mfma_f32_32x32x16_bf16((a), (b), (c), 0, 0, 0)

constexpr int DK_LP = 272, DV_LP = 320, DK_BUF = 64 * DK_LP, DV_BUF = 64 * DV_LP;
__device__ __forceinline__ void diff_unit(LAS unsigned char* lds, const bf16_t* QD, const bf16_t* KD, const bf16_t* VD, bf16_t* ACAT, int qrow0, int kr0, int NT, int h,
                                          float lam, float outscale, const float* subln, int tstart, int wave0) {
    const int tid = mk_tid(wave0);
    const int lane = tid & 63, w = __builtin_amdgcn_readfirstlane(tid >> 6), r32 = lane & 31, hi = lane >> 5, c = w >> 2, wq = w & 3;
    bf16x8 qf[4];
    { const bf16_t* qp = QD + (size_t)(qrow0 + 32 * wq + r32) * 512 + h * 128 + c * 64 + hi * 8;
#pragma unroll
      for (int s = 0; s < 4; ++s) qf[s] = __builtin_bit_cast(bf16x8, gld16(qp + 16 * s)); }
    const int srow0 = tid >> 4, sch = tid & 15;
    const bf16_t* ksrc = KD + (size_t)(kr0 + srow0) * 512 + h * 128 + sch * 8;
    const bf16_t* vsrc = VD + (size_t)(kr0 + srow0) * 512 + h * 128 + sch * 8;
    const int kdst = srow0 * DK_LP + sch * 16, vdst = 2 * DK_BUF + srow0 * DV_LP + sch * 16;
#define TROT(t) (((t) + tstart) % NT)
#define LBAR() asm volatile("s_waitcnt lgkmcnt(0)\n\ts_barrier" ::: "memory")
#define D_LOAD(K_, V_, t) do { const int tt_ = TROT(t); _Pragma("unroll") for (int p_ = 0; p_ < 2; ++p_) { K_[p_] = gld16(ksrc + (size_t)(tt_ * 64 + 32 * p_) * 512); V_[p_] = gld16(vsrc + (size_t)(tt_ * 64 + 32 * p_) * 512); } } while (0)
#define D_WRITE(K_, V_, b) do { _Pragma("unroll") for (int p_ = 0; p_ < 2; ++p_) { *(LAS u32x4*)(lds + (b) * DK_BUF + kdst + p_ * 32 * DK_LP) = K_[p_]; *(LAS u32x4*)(lds + (b) * DV_BUF + vdst + p_ * 32 * DV_LP) = V_[p_]; } } while (0)
    const int kfoff = r32 * DK_LP + c * 128 + hi * 16;
    const int g4 = lane >> 4, i16 = lane & 15;
    const int vfoff = 2 * DK_BUF + (4 * (g4 >> 1) + (i16 >> 2)) * DV_LP + (16 * (g4 & 1) + 4 * (i16 & 3)) * 2;
    u32x4 kA[2], vA[2], kB[2], vB[2];
    D_LOAD(kA, vA, 0); D_LOAD(kB, vB, 1);
    D_WRITE(kA, vA, 0);
    LBAR();
    f32x16 o[4];
#pragma unroll
    for (int d = 0; d < 4; ++d)
#pragma unroll
        for (int r = 0; r < 16; ++r) o[d][r] = 0.f;
    float lsum = 0.f;
#define SGB(mask, n) __builtin_amdgcn_sched_group_barrier((mask), (n), 0)
#define D_VLOAD(S_, ks) do { _Pragma("unroll") for (int dt = 0; dt < 4; ++dt) { S_[2 * dt] = vtr(vb + (ks) * 16 * DV_LP + dt * 64); S_[2 * dt + 1] = vtr(vb + (ks) * 16 * DV_LP + 8 * DV_LP + dt * 64); } } while (0)
#define D_PV(S_, ks) do { const bf16x8 pa = ((ks) < 2) ? packp(p0, (ks) & 1) : packp(p1, (ks) & 1); \
        _Pragma("unroll") for (int dt = 0; dt < 4; ++dt) { const s16x4 lo = S_[2 * dt], hh = S_[2 * dt + 1]; \
            const bf16x8 vf = (bf16x8){lo[0], lo[1], lo[2], lo[3], hh[0], hh[1], hh[2], hh[3]}; o[dt] = MFMA32(pa, vf, o[dt]); } } while (0)
#define D_ITER(t, KL, VL, KW, VW) do { \
        const int b = (t) & 1; \
        if ((t) + 2 < NT) D_LOAD(KL, VL, (t) + 2); \
        f32x16 p0, p1; \
        _Pragma("unroll") for (int r = 0; r < 16; ++r) { p0[r] = 0.f; p1[r] = 0.f; } \
        const LAS unsigned char* kb = lds + b * DK_BUF + kfoff; \
        const LAS unsigned char* vb = lds + b * DV_BUF + vfoff; \
        bf16x8 kf[8]; s16x4 va[8], vc[8]; \
        _Pragma("unroll") for (int s = 0; s < 4; ++s) { kf[2 * s] = *(const LAS bf16x8*)(kb + s * 32); kf[2 * s + 1] = *(const LAS bf16x8*)(kb + 32 * DK_LP + s * 32); } \
        D_VLOAD(va, 0); \
        _Pragma("unroll") for (int s = 0; s < 4; ++s) { p0 = MFMA32(kf[2 * s], qf[s], p0); p1 = MFMA32(kf[2 * s + 1], qf[s], p1); } \
        SGB(0x100, 16); SGB(0x008, 8); \
        float ls = 0.f; \
        _Pragma("unroll") for (int r = 0; r < 16; ++r) { p0[r] = __builtin_amdgcn_exp2f(p0[r]); p1[r] = __builtin_amdgcn_exp2f(p1[r]); ls += p0[r] + p1[r]; } \
        lsum += ls; \
        D_VLOAD(vc, 1); D_PV(va, 0); SGB(0x100, 8); SGB(0x008, 4); \
        D_VLOAD(va, 2); D_PV(vc, 1); SGB(0x100, 8); SGB(0x008, 4); \
        D_VLOAD(vc, 3); D_PV(va, 2); SGB(0x100, 8); SGB(0x008, 4); \
        D_PV(vc, 3); \
        if ((t) + 1 < NT) D_WRITE(KW, VW, b ^ 1); \
        LBAR(); \
    } while (0)
    for (int t = 0; t < NT; t += 2) {
        D_ITER(t, kA, vA, kB, vB);
        D_ITER(t + 1, kB, vB, kA, vA);
    }
#undef D_ITER
#undef D_VLOAD
#undef D_PV
#undef D_LOAD
#undef D_WRITE
#undef TROT
    lsum += __shfl_xor(lsum, 32);
    const float linv = 1.0f / lsum;
#pragma unroll
    for (int r = 0; r < 16; ++r) { const float l_ = __shfl(linv, crow(r, hi));
#pragma unroll
        for (int dt = 0; dt < 4; ++dt) o[dt][r] *= l_; }
    LAS float* xch = (LAS float*)lds;
    if (c == 1) {
#pragma unroll
        for (int dt = 0; dt < 4; ++dt)
#pragma unroll
            for (int r = 0; r < 16; ++r) xch[((wq * 4 + dt) * 16 + r) * 64 + lane] = o[dt][r];
    }
    __syncthreads();
    if (c == 0) {
        float ss[16];
#pragma unroll
        for (int r = 0; r < 16; ++r) ss[r] = 0.f;
#pragma unroll
        for (int dt = 0; dt < 4; ++dt)
#pragma unroll
            for (int r = 0; r < 16; ++r) { const float v = o[dt][r] - lam * xch[((wq * 4 + dt) * 16 + r) * 64 + lane]; o[dt][r] = v; ss[r] += v * v; }
#pragma unroll
        for (int r = 0; r < 16; ++r) {
            float s = ss[r];
            s += __shfl_xor(s, 1); s += __shfl_xor(s, 2); s += __shfl_xor(s, 4); s += __shfl_xor(s, 8); s += __shfl_xor(s, 16);
            ss[r] = rsqrtf(s * (1.0f / 128.0f) + EPSF) * outscale;
        }
#pragma unroll
        for (int dt = 0; dt < 4; ++dt) {
            const float gsl = subln[32 * dt + r32];
#pragma unroll
            for (int r = 0; r < 16; ++r) {
                const float v = o[dt][r] * ss[r] * gsl;
                ACAT[(size_t)(qrow0 + 32 * wq + crow(r, hi)) * 1536 + 512 + h * 128 + 32 * dt + r32] = (bf16_t)(pk2(v, 0.f) & 0xffffu);
            }
        }
    }
    __syncthreads();
}

constexpr int MK_LP = 208, MV_LP = 192, MK_BUF = 64 * MK_LP, MV_BUF = 64 * MV_LP;
__device__ __forceinline__ void mla_unit(LAS unsigned char* lds, const bf16_t* QM, const float* qss, const float* cqpart, const bf16_t* KM, const bf16_t* VM, bf16_t* ACAT,
                                         int qrow0, int kr0, int NT, int h, int tstart, int wave0) {
    const int tid = mk_tid(wave0);
    const int lane = tid & 63, w = __builtin_amdgcn_readfirstlane(tid >> 6), r32 = lane & 31, hi = lane >> 5;
    bf16x8 qf[6];
    {
        const int row = qrow0 + 32 * w + r32;
        const f32x4 c0 = *(const f32x4*)(cqpart + (size_t)row * 8), c1 = *(const f32x4*)(cqpart + (size_t)row * 8 + 4);
        const float r1 = rsqrtf((sum4(c0) + sum4(c1)) * (1.0f / 384.0f) + EPSF);
        const float qs = qss[(size_t)row * 24 + 3 * h] + qss[(size_t)row * 24 + 3 * h + 1] + qss[(size_t)row * 24 + 3 * h + 2];
        const float sq = r1 * rsqrtf(r1 * r1 * qs * (1.0f / 96.0f) + EPSF);
        const float fq_ = sq * 0.10206207261596575f * LOG2E;
        const bf16_t* qp = QM + (size_t)row * 768 + 96 * h + hi * 8;
#pragma unroll
        for (int s = 0; s < 6; ++s) {
            const u32x4 q = gld16(qp + 16 * s);
            u32x4 z; z.x = pk2(bflo(q.x) * fq_, bfhi(q.x) * fq_); z.y = pk2(bflo(q.y) * fq_, bfhi(q.y) * fq_); z.z = pk2(bflo(q.z) * fq_, bfhi(q.z) * fq_); z.w = pk2(bflo(q.w) * fq_, bfhi(q.w) * fq_);
            qf[s] = __builtin_bit_cast(bf16x8, z);
        }
    }
    const int kr_a = tid / 12, kc_a = tid - 12 * kr_a; const int cb = 512 + tid; const int kr_b = cb / 12, kc_b = cb - 12 * kr_b; const bool has_b = tid < 256;
    const bf16_t* ksrc_a = KM + (size_t)(kr0 + kr_a) * 768 + 96 * h + kc_a * 8;
    const bf16_t* ksrc_b = KM + (size_t)(kr0 + kr_b) * 768 + 96 * h + kc_b * 8;
    const bf16_t* vsrc = VM + (size_t)(kr0 + (tid >> 3)) * 512 + 64 * h + (tid & 7) * 8;
    const int kdst_a = kr_a * MK_LP + kc_a * 16, kdst_b = kr_b * MK_LP + kc_b * 16, vdst = 2 * MK_BUF + (tid >> 3) * MV_LP + (tid & 7) * 16;
#define TROT(t) (((t) + tstart) % NT)
#define M_LOAD(KA_, KB_, V_, t) do { const int tt_ = TROT(t); KA_ = gld16(ksrc_a + (size_t)tt_ * 64 * 768); if (has_b) KB_ = gld16(ksrc_b + (size_t)tt_ * 64 * 768); V_ = gld16(vsrc + (size_t)tt_ * 64 * 512); } while (0)
#define M_WRITE(KA_, KB_, V_, b) do { *(LAS u32x4*)(lds + (b) * MK_BUF + kdst_a) = KA_; if (has_b) *(LAS u32x4*)(lds + (b) * MK_BUF + kdst_b) = KB_; *(LAS u32x4*)(lds + (b) * MV_BUF + vdst) = V_; } while (0)
    const int kfoff = r32 * MK_LP + hi * 16;
    const int g4 = lane >> 4, i16 = lane & 15;
    const int vfoff = 2 * MK_BUF + (4 * (g4 >> 1) + (i16 >> 2)) * MV_LP + (16 * (g4 & 1) + 4 * (i16 & 3)) * 2;
    u32x4 kaA, kbA, vA, kaB, kbB, vB;
    kbA = (u32x4){0u, 0u, 0u, 0u}; kbB = kbA;
    M_LOAD(kaA, kbA, vA, 0); M_LOAD(kaB, kbB, vB, 1);
    M_WRITE(kaA, kbA, vA, 0);
    LBAR();
    f32x16 o[2];
#pragma unroll
    for (int d = 0; d < 2; ++d)
#pragma unroll
        for (int r = 0; r < 16; ++r) o[d][r] = 0.f;
    float lsum = 0.f;
#define M_VLOAD(S_, ks) do { _Pragma("unroll") for (int dt = 0; dt < 2; ++dt) { S_[2 * dt] = vtr(vb + (ks) * 16 * MV_LP + dt * 64); S_[2 * dt + 1] = vtr(vb + (ks) * 16 * MV_LP + 8 * MV_LP + dt * 64); } } while (0)
#define M_PV(S_, ks) do { const bf16x8 pa = ((ks) < 2) ? packp(p0, (ks) & 1) : packp(p1, (ks) & 1); \
        _Pragma("unroll") for (int dt = 0; dt < 2; ++dt) { const s16x4 lo = S_[2 * dt], hh = S_[2 * dt + 1]; \
            const bf16x8 vf = (bf16x8){lo[0], lo[1], lo[2], lo[3], hh[0], hh[1], hh[2], hh[3]}; o[dt] = MFMA32(pa, vf, o[dt]); } } while (0)
#define M_ITER(t, KAL, KBL, VL, KAW, KBW, VW) do { \
        const int b = (t) & 1; \
        if ((t) + 2 < NT) M_LOAD(KAL, KBL, VL, (t) + 2); \
        f32x16 p0, p1; \
        _Pragma("unroll") for (int r = 0; r < 16; ++r) { p0[r] = 0.f; p1[r] = 0.f; } \
        const LAS unsigned char* kb = lds + b * MK_BUF + kfoff; \
        const LAS unsigned char* vb = lds + b * MV_BUF + vfoff; \
        bf16x8 kf[12]; s16x4 va[4], vc[4]; \
        _Pragma("unroll") for (int s = 0; s < 6; ++s) { kf[2 * s] = *(const LAS bf16x8*)(kb + s * 32); kf[2 * s + 1] = *(const LAS bf16x8*)(kb + 32 * MK_LP + s * 32); } \
        M_VLOAD(va, 0); \
        _Pragma("unroll") for (int s = 0; s < 6; ++s) { p0 = MFMA32(kf[2 * s], qf[s], p0); p1 = MFMA32(kf[2 * s + 1], qf[s], p1); } \
        SGB(0x100, 16); SGB(0x008, 12); \
        float ls = 0.f; \
        _Pragma("unroll") for (int r = 0; r < 16; ++r) { p0[r] = __builtin_amdgcn_exp2f(p0[r]); p1[r] = __builtin_amdgcn_exp2f(p1[r]); ls += p0[r] + p1[r]; } \
        lsum += ls; \
        M_VLOAD(vc, 1); M_PV(va, 0); SGB(0x100, 4); SGB(0x008, 2); \
        M_VLOAD(va, 2); M_PV(vc, 1); SGB(0x100, 4); SGB(0x008, 2); \
        M_VLOAD(vc, 3); M_PV(va, 2); SGB(0x100, 4); SGB(0x008, 2); \
        M_PV(vc, 3); \
        if ((t) + 1 < NT) M_WRITE(KAW, KBW, VW, b ^ 1); \
        LBAR(); \
    } while (0)
    for (int t = 0; t < NT; t += 2) {
        M_ITER(t, kaA, kbA, vA, kaB, kbB, vB);
        M_ITER(t + 1, kaB, kbB, vB, kaA, kbA, vA);
    }
#undef M_ITER
#undef M_VLOAD
#undef M_PV
#undef SGB
#undef M_LOAD
#undef M_WRITE
#undef TROT
#undef LBAR
    lsum += __shfl_xor(lsum, 32);
    const float linv = 1.0f / lsum;
#pragma unroll
    for (int r = 0; r < 16; ++r) {
        const float l = __shfl(linv, crow(r, hi));
#pragma unroll
        for (int dt = 0; dt < 2; ++dt) {
            const float v = o[dt][r] * l;
            ACAT[(size_t)(qrow0 + 32 * w + crow(r, hi)) * 1536 + 1024 + 64 * h + 32 * dt + r32] = (bf16_t)(pk2(v, 0.f) & 0xffffu);
        }
    }
}

__device__ __forceinline__ void conv_item(LAS unsigned char* lds, const bf16_t* U, const float* dw, const float* cb, const float* gn, bf16_t* ACAT, int item, int wave0) {
    const int tid = mk_tid(wave0);
    const int lane = tid & 63, w = __builtin_amdgcn_readfirstlane(tid >> 6);
    const int cp = tid & 255, th = tid >> 8;
    const int t0 = item * 32;
    const int sstart = t0 < 4096 ? (t0 & ~255) : 4096 + ((t0 - 4096) & ~2047), send = sstart + (t0 < 4096 ? 256 : 2048);
    LAS float* red = (LAS float*)(lds + 126976);
    LAS float* rinvs = (LAS float*)(lds + 127488);
    {
        u32x4 v[8]; f32x4 wq[8];
#pragma unroll
        for (int k = 0; k < 8; ++k) {
            const int cidx = tid + 512 * k, r = cidx >> 6, ch = cidx & 63, row = t0 - 15 + r;
            v[k] = (u32x4){0u, 0u, 0u, 0u}; wq[k] = (f32x4){0.f, 0.f, 0.f, 0.f};
            if (cidx < 3968) { wq[k] = gldf4(dw + (size_t)cidx * 4); if (row >= sstart && row < send) v[k] = gld16(U + (size_t)row * 512 + ch * 8); }
        }
#pragma unroll
        for (int k = 0; k < 8; ++k) { const int cidx = tid + 512 * k; if (cidx < 3968) { *(LAS u32x4*)(lds + cidx * 16) = v[k]; *(LAS f32x4*)(lds + 63488 + cidx * 16) = wq[k]; } }
    }
    __syncthreads();
    float a0[16], a1[16];
#pragma unroll
    for (int i = 0; i < 16; ++i) { a0[i] = 0.f; a1[i] = 0.f; }
    const LAS unsigned char* ubase = lds + (16 * th) * 1024 + cp * 4;
    const LAS unsigned char* wbase = lds + 63488 + cp * 8;
#pragma unroll 1
    for (int j = 0; j < 31; ++j) {
        const f32x2_t wj = *(const LAS f32x2_t*)(wbase + j * 2048);
        const LAS unsigned char* up = ubase + j * 1024;
#pragma unroll
        for (int i = 0; i < 16; ++i) { const unsigned x = *(const LAS unsigned*)(up + i * 1024); a0[i] += wj.x * bflo(x); a1[i] += wj.y * bfhi(x); }
    }
    { const float b0 = cb[2 * cp], b1 = cb[2 * cp + 1];
#pragma unroll
      for (int i = 0; i < 16; ++i) { a0[i] += b0; a1[i] += b1; } }
#pragma unroll
    for (int i = 0; i < 16; ++i) { const float sq = wave_sum(a0[i] * a0[i] + a1[i] * a1[i]); if (lane == 0) red[(16 * th + i) * 4 + (w & 3)] = sq; }
    __syncthreads();
    if (tid < 32) { const f32x4 r4 = *(const LAS f32x4*)(red + tid * 4); rinvs[tid] = rsqrtf(sum4(r4) * (1.0f / 512.0f) + EPSF); }
    __syncthreads();
    const float g0 = gn[2 * cp], g1 = gn[2 * cp + 1];
#pragma unroll
    for (int i = 0; i < 16; ++i) {
        const float ri = rinvs[16 * th + i];
        const float v0 = a0[i] * ri * g0, v1 = a1[i] * ri * g1;
        *(unsigned*)(ACAT + (size_t)(t0 + 16 * th + i) * 1536 + 2 * cp) = pk2(v0 * sigmoidf_(v0), v1 * sigmoidf_(v1));
    }
    __syncthreads();
}

__device__ __forceinline__ int perm_off(int type, int rho) {
    const int n = rho >> 4, fq = (rho >> 2) & 3, i = rho & 3;
    return type == 0 ? rho : (type == 1 ? 8 * fq + 4 * n + i : 16 * (fq >> 1) + 8 * n + 4 * (fq & 1) + i);
}
struct TrItem { const float* W; const float* ksc; bf16_t* WT; int ldw, k0, n0, ldt, drow0, dk0, pt; };
__device__ __forceinline__ void tr_load(const TrItem& it, f32x4 (&v)[8], int lane) {
    const int rsub = lane >> 3, c4 = lane & 7;
#pragma unroll
    for (int i = 0; i < 8; ++i) { v[i] = (f32x4){0.f, 0.f, 0.f, 0.f}; if (it.n0 >= 0) v[i] = gldf4(it.W + (size_t)(it.k0 + 8 * i + rsub) * it.ldw + it.n0 + 4 * c4); }
}
__device__ __forceinline__ void tr_process(const TrItem& it, const f32x4 (&v)[8], LAS float* scr, int lane) {
    const int rsub = lane >> 3, c4 = lane & 7;
#pragma unroll
    for (int i = 0; i < 8; ++i) { const int kk = 8 * i + rsub; f32x4 x = v[i]; if (it.ksc) x = x * it.ksc[it.k0 + kk]; LAS float* d = scr + kk * 33 + 4 * c4; d[0] = x[0]; d[1] = x[1]; d[2] = x[2]; d[3] = x[3]; }
    LDS_WAIT(); asm volatile("" ::: "memory");
    const int c = lane & 7;
#pragma unroll
    for (int j = 0; j < 4; ++j) { const int rho = (lane >> 3) + 8 * j; const LAS float* sp = scr + (8 * c) * 33 + perm_off(it.pt, rho);
        u32x4 o; o.x = pk2(sp[0 * 33], sp[1 * 33]); o.y = pk2(sp[2 * 33], sp[3 * 33]); o.z = pk2(sp[4 * 33], sp[5 * 33]); o.w = pk2(sp[6 * 33], sp[7 * 33]);
        *(GAS u32x4*)(unsigned long long)(uintptr_t)(it.WT + (size_t)(it.drow0 + rho) * it.ldt + it.dk0 + 8 * c) = o; }
    LDS_WAIT(); asm volatile("" ::: "memory");
}
__device__ __forceinline__ void gemv3_item(const float* W, int ldw, int ncols, int n0, const LAS float* vec, LAS float* red, float* o0, float* o1, float* o2, const float* addb, int wave, int lane) {
    const int n = n0 + 4 * (lane & 15), rsub = lane >> 4; const bool ok = n < ncols;
    f32x4 a0 = (f32x4){0.f, 0.f, 0.f, 0.f}, a1 = a0, a2 = a0;
    const float* wp = W + (size_t)(128 * wave + rsub) * ldw + (ok ? n : n0);
#pragma unroll 16
    for (int it = 0; it < 32; ++it) { const f32x4 wv = gldf4(wp + (size_t)(4 * it) * ldw); const int k = 128 * wave + 4 * it + rsub; a0 += wv * vec[k]; a1 += wv * vec[1024 + k]; a2 += wv * vec[2048 + k]; }
#pragma unroll
    for (int i = 0; i < 4; ++i) { a0[i] += __shfl_xor(a0[i], 16); a0[i] += __shfl_xor(a0[i], 32); a1[i] += __shfl_xor(a1[i], 16); a1[i] += __shfl_xor(a1[i], 32); a2[i] += __shfl_xor(a2[i], 16); a2[i] += __shfl_xor(a2[i], 32); }
    if (lane < 16) { *(LAS f32x4*)(red + (wave * 3 + 0) * 64 + 4 * lane) = a0; *(LAS f32x4*)(red + (wave * 3 + 1) * 64 + 4 * lane) = a1; *(LAS f32x4*)(red + (wave * 3 + 2) * 64 + 4 * lane) = a2; }
    __syncthreads();
    if (wave < 3) { float sacc = 0.f; const int nn = n0 + lane;
#pragma unroll
        for (int k = 0; k < 8; ++k) sacc += red[(k * 3 + wave) * 64 + lane];
        const bool ok2 = nn < ncols;
        if (addb && ok2) sacc += addb[nn];
        float* op = wave == 0 ? o0 : (wave == 1 ? o1 : o2);
        if (ok2) op[nn] = sacc; }
    __syncthreads();
}

#define XB_TMO      128
#define XB_XCNT(j)  (256  + 64 * (j))
#define XB_XSUB(j)  (1280 + 64 * (j))
#define XB_XGEN(j)  (2304 + 64 * (j))
#define XB_TOP      3328
#define XB_TOPGEN   3392
#define XCD_BAR_WORDS 3456
#define XB_SPIN_CAP (1u << 18)
__device__ __forceinline__ unsigned xb_ld(unsigned* p)              { return __hip_atomic_load(p, __ATOMIC_RELAXED, __HIP_MEMORY_SCOPE_AGENT); }
__device__ __forceinline__ unsigned xb_add(unsigned* p, unsigned v) { return __hip_atomic_fetch_add(p, v, __ATOMIC_RELAXED, __HIP_MEMORY_SCOPE_AGENT); }
__device__ __forceinline__ unsigned xb_xcc_id() { return (unsigned)__builtin_amdgcn_s_getreg((3 << 11) | 20) & 0xFu; }
#define XB_SPIN(cond, bar) do { unsigned _sp = 0; while (cond) { __builtin_amdgcn_s_sleep(1); \
    if ((++_sp & 255u) == 0u) { if (xb_ld(&(bar)[XB_TMO])) break; if (_sp > XB_SPIN_CAP) { atomicAdd(&(bar)[XB_TMO], 1u); break; } } } } while (0)
struct XcdBarrier { unsigned* bar; unsigned x; volatile LAS unsigned* st; };
__device__ __forceinline__ XcdBarrier xcd_barrier_post(unsigned* bar, volatile LAS unsigned* st, int tid) {
    XcdBarrier b; b.bar = bar; b.x = xb_xcc_id(); b.st = st;
    if (tid == 0) (void)xb_add(&bar[XB_XCNT(b.x)], 1u);
    return b;
}
__device__ __forceinline__ void xcd_barrier_complete(unsigned* bar, unsigned x, unsigned& nloc, unsigned& nx) {
    const unsigned G = gridDim.x * gridDim.y * gridDim.z;
    unsigned sum, cnt, mine, sp = 0u;
    for (;;) {
        sum = 0u; cnt = 0u; mine = 0u;
#pragma unroll
        for (unsigned j = 0; j < 16; ++j) { const unsigned c = xb_ld(&bar[XB_XCNT(j)]); sum += c; cnt += (c > 0u) ? 1u : 0u; mine = (j == x) ? c : mine; }
        if (sum == G) break;
        __builtin_amdgcn_s_sleep(1);
        if ((++sp & 255u) == 0u) { if (xb_ld(&bar[XB_TMO])) break; if (sp > XB_SPIN_CAP) { atomicAdd(&bar[XB_TMO], 1u); break; } }
    }
    nloc = mine > 0u ? mine : 1u; nx = cnt > 0u ? cnt : 1u;
}
__device__ __forceinline__ void xcd_barrier(const XcdBarrier& b0, int tid) {
    asm volatile("s_waitcnt vmcnt(0)" ::: "memory");
    __syncthreads();
    if (tid == 0) {
        XcdBarrier b; b.bar = launder(b0.bar); b.x = xb_xcc_id(); b.st = b0.st;
        unsigned* bar = b.bar;
        __builtin_amdgcn_s_waitcnt(0);
        unsigned nloc = b.st[0], nx = b.st[1];
        if (nloc == 0u) { xcd_barrier_complete(bar, b.x, nloc, nx); b.st[0] = nloc; b.st[1] = nx; }
        const unsigned old = xb_add(&bar[XB_XSUB(b.x)], 1u);
        const unsigned gen = old / nloc;
        if (old + 1u == (gen + 1u) * nloc) {
            __builtin_amdgcn_fence(__ATOMIC_RELEASE, "agent");
            asm volatile("s_waitcnt vmcnt(0)" ::: "memory");
            const unsigned og = xb_add(&bar[XB_TOP], 1u);
            const unsigned tg = og / nx;
            if (og + 1u == (tg + 1u) * nx) xb_add(&bar[XB_TOPGEN], 1u);
            else XB_SPIN(xb_ld(&bar[XB_TOPGEN]) == tg, bar);
            __builtin_amdgcn_fence(__ATOMIC_ACQUIRE, "agent");
            xb_add(&bar[XB_XGEN(b.x)], 1u);
            asm volatile("s_waitcnt vmcnt(0)" ::: "memory");
        } else {
            XB_SPIN(xb_ld(&bar[XB_XGEN(b.x)]) == gen, bar);
            __builtin_amdgcn_fence(__ATOMIC_ACQUIRE, "agent");
            asm volatile("s_waitcnt vmcnt(0)" ::: "memory");
        }
    }
    __syncthreads();
}

struct Args { const float* in[32]; float* out; unsigned char* ws; int ph_lo, ph_hi; };
enum { I_XP = 0, I_XS, I_CDK, I_CDV, I_CCKV, I_CKPE, I_C, I_CCTX, I_MODW, I_MODB, I_N1G, I_WIN, I_CDW, I_CB, I_CNG, I_WCO, I_DQN, I_DKN, I_DLAM, I_DSUB, I_WDO,
       I_QAN, I_KVAN, I_WUQ, I_WUKV, I_MQN, I_MKN, I_WMO, I_WOUT, I_N2G, I_WUP, I_WDOWN };
constexpr int NPHASES = 18;

#define TAB_OFF (LDSCTL_OFF + 256)
__device__ __forceinline__ const float* inp(LAS unsigned char* lds, int i) {
    int i2 = i; asm volatile("" : "+s"(i2));
    const unsigned long long v = ((volatile LAS unsigned long long*)(lds + TAB_OFF))[i2];
    const unsigned lo = __builtin_amdgcn_readfirstlane((unsigned)v), hi = __builtin_amdgcn_readfirstlane((unsigned)(v >> 32));
    return (const float*)(GAS const float*)(((unsigned long long)hi << 32) | lo);
}

__device__ __forceinline__ void convert_layer(LAS unsigned char* lds, unsigned char* ws, int l, int it_lo, int it_hi, bool do_cache, int gw, int NGW, int gtid, int NGT, int lane, int wave) {
    LAS float* scr = (LAS float*)(lds + wave * 16384);
    constexpr int I1 = 200 * 16, I2A = 24 * 6, I2B = 32 * 4, I4 = 32 * 24, I5 = 32 * 16, I6 = 128 * 16, I7 = 32 * 64;
    constexpr int NITEMS = I1 + I2A + I2B + I4 + I5 + I6 + I7;
    if (it_hi > NITEMS) it_hi = NITEMS;
#define TR_DECODE(IT_, itidx) do { \
        int r = (itidx); \
        const float* W; const float* ksc = nullptr; bf16_t* WT; int ldw, k0, n0, ldt, drow0, dk0, pt = 1; \
        if (r < I1) { const int kb = r / 200, db = r - 200 * kb; const int pn = db >> 3, bj = (db >> 2) & 1, wc = db & 3; \
            if (pn < 4) n0 = bj * 512 + 128 * pn + 32 * wc; \
            else if (pn < 8) { n0 = (pn < 6 ? 1024 : 1536) + 256 * ((pn - 4) & 1) + 64 * wc + 32 * bj; pt = 0; } \
            else if (pn < 10) n0 = 2048 + 256 * (pn - 8) + 128 * bj + 32 * wc; \
            else if (pn == 10) n0 = 2560 + 128 * bj + 32 * wc; \
            else if (pn == 11) n0 = bj == 0 ? 2816 + 32 * wc : (wc == 0 ? 3200 : -1); \
            else if (pn == 12) n0 = 2944 + 128 * bj + 32 * wc; \
            else n0 = 3232 + 256 * (pn - 13) + 128 * bj + 32 * wc; \
            W = inp(lds, I_WIN) + (size_t)l * 1024 * NIN; ldw = NIN; k0 = 64 * kb; WT = (bf16_t*)(ws + WS_BT1); ldt = 1024; drow0 = 32 * db; dk0 = 64 * kb; } \
        else if ((r -= I1) < I2A) { const int kb = r / 24, blk = r - 24 * kb; const int h = blk / 3, part = blk - 3 * h; \
            W = inp(lds, I_WUQ) + (size_t)l * 384 * 768; ldw = 768; k0 = 64 * kb; n0 = 96 * h + 32 * part; WT = (bf16_t*)(ws + WS_BT2A); ldt = 384; drow0 = 32 * blk; dk0 = 64 * kb; pt = part == 2 ? 2 : 0; ksc = inp(lds, I_QAN) + l * 384; } \
        else if ((r -= I2A) < I2B) { const int kb = r >> 5, db = r & 31; const int pn = db >> 3, bj = (db >> 2) & 1, wc = db & 3; \
            if (pn < 2) { n0 = 128 * (4 * pn + wc) + 32 * bj; pt = 0; } else { n0 = 128 * (4 * (pn - 2) + 2 * bj + (wc >> 1)) + 64 + 32 * (wc & 1); pt = 1; } \
            W = inp(lds, I_WUKV) + (size_t)l * 256 * 1024; ldw = 1024; k0 = 64 * kb; WT = (bf16_t*)(ws + WS_BT2B); ldt = 256; drow0 = 32 * db; dk0 = 64 * kb; ksc = inp(lds, I_KVAN) + l * 256; } \
        else if ((r -= I2B) < I4) { const int kb = r >> 5, db = r & 31; const int sg = kb >> 3; \
            W = inp(lds, sg == 0 ? I_WCO : (sg == 1 ? I_WDO : I_WMO)) + (size_t)l * 512 * 1024; ldw = 1024; k0 = 64 * (kb & 7); n0 = 32 * db; WT = (bf16_t*)(ws + (l == 0 ? WS_BT4 : WS_BT4B)); ldt = 1536; drow0 = 32 * db; dk0 = 64 * kb; } \
        else if ((r -= I4) < I5) { const int kb = r >> 5, db = r & 31; W = inp(lds, I_WOUT) + (size_t)l * 1024 * 1024; ldw = 1024; k0 = 64 * kb; n0 = 32 * db; WT = (bf16_t*)(ws + (l == 0 ? WS_BT5 : WS_BT5B)); ldt = 1024; drow0 = 32 * db; dk0 = 64 * kb; } \
        else if ((r -= I5) < I6) { const int kb = r >> 7, db = r & 127; W = inp(lds, I_WUP) + (size_t)l * 1024 * 4096; ldw = 4096; k0 = 64 * kb; n0 = 32 * db; WT = (bf16_t*)(ws + (l == 0 ? WS_BT6 : WS_BT6B)); ldt = 1024; drow0 = 32 * db; dk0 = 64 * kb; } \
        else { r -= I6; const int kb = r >> 5, db = r & 31; W = inp(lds, I_WDOWN) + (size_t)l * 4096 * 1024; ldw = 1024; k0 = 64 * kb; n0 = 32 * db; WT = (bf16_t*)(ws + (l == 0 ? WS_BT7 : WS_BT7B)); ldt = 4096; drow0 = 32 * db; dk0 = 64 * kb; } \
        IT_.W = W; IT_.ksc = ksc; IT_.WT = WT; IT_.ldw = ldw; IT_.k0 = k0; IT_.n0 = n0; IT_.ldt = ldt; IT_.drow0 = drow0; IT_.dk0 = dk0; IT_.pt = pt; } while (0)
    {
        int it = it_lo + gw;
        TrItem A, B; f32x4 va[8], vb[8];
        if (it < it_hi) { TR_DECODE(A, it); tr_load(A, va, lane); }
        while (it < it_hi) {
            const bool hasB = it + NGW < it_hi;
            if (hasB) { TR_DECODE(B, it + NGW); tr_load(B, vb, lane); }
            tr_process(A, va, scr, lane);
            it += NGW;
            if (!hasB) break;
            const bool hasA = it + NGW < it_hi;
            if (hasA) { TR_DECODE(A, it + NGW); tr_load(A, va, lane); }
            tr_process(B, vb, scr, lane);
            it += NGW;
        }
    }
#undef TR_DECODE
    if (!do_cache) return;
    bf16_t* KD = (bf16_t*)(ws + WS_KD); bf16_t* VD = (bf16_t*)(ws + WS_VD); bf16_t* CKVA = (bf16_t*)(ws + WS_CKVA);
    float* KPER = (float*)(ws + WS_KPER); float* KPESS = (float*)(ws + WS_KPESS);
    { const float* cdk = inp(lds, I_CDK); const float* cdv = inp(lds, I_CDV);
    for (int ci = gtid; ci < 512 * 64; ci += NGT) {
        const int row = ci >> 6, c8 = ci & 63, b = row >> 8, j = row & 255;
        const size_t src = ((size_t)(b * 2 + l) * 256 + j) * 512 + 8 * c8; const size_t dst = (size_t)(4096 + b * 2304 + j) * 512 + 8 * c8;
        { const f32x4 x0 = *(const f32x4*)(cdk + src), x1 = *(const f32x4*)(cdk + src + 4);
          u32x4 w; w.x = pk2(x0[0], x0[1]); w.y = pk2(x0[2], x0[3]); w.z = pk2(x1[0], x1[1]); w.w = pk2(x1[2], x1[3]); *(u32x4*)(KD + dst) = w; }
        { const f32x4 x0 = *(const f32x4*)(cdv + src), x1 = *(const f32x4*)(cdv + src + 4);
          u32x4 w; w.x = pk2(x0[0], x0[1]); w.y = pk2(x0[2], x0[3]); w.z = pk2(x1[0], x1[1]); w.w = pk2(x1[2], x1[3]); *(u32x4*)(VD + dst) = w; }
    } }
    { const float* cckv = inp(lds, I_CCKV); const float* gk = inp(lds, I_KVAN) + l * 256;
    for (int ci = gtid; ci < 512 * 32; ci += NGT) {
        const int row = ci >> 5, c8 = ci & 31, b = row >> 8, j = row & 255;
        const size_t src = ((size_t)(b * 2 + l) * 256 + j) * 256 + 8 * c8;
        const float* g = gk + 8 * c8;
        const f32x4 x0 = *(const f32x4*)(cckv + src) / *(const f32x4*)g, x1 = *(const f32x4*)(cckv + src + 4) / *(const f32x4*)(g + 4);
        u32x4 w; w.x = pk2(x0[0], x0[1]); w.y = pk2(x0[2], x0[3]); w.z = pk2(x1[0], x1[1]); w.w = pk2(x1[2], x1[3]);
        *(u32x4*)(CKVA + (size_t)(8192 + row) * 256 + 8 * c8) = w;
    } }
    { const float* ckpe = inp(lds, I_CKPE);
    for (int row = gtid; row < 512; row += NGT) {
        const int b = row >> 8, j = row & 255; const float* src = ckpe + ((size_t)(b * 2 + l) * 256 + j) * 32; float ss = 0.f;
#pragma unroll
        for (int q = 0; q < 8; ++q) { const f32x4 x = *(const f32x4*)(src + 4 * q); *(f32x4*)(KPER + (size_t)(8192 + row) * 32 + 4 * q) = x; ss += sum4(x * x); }
        KPESS[8192 + row] = ss;
    } }
}

__global__ void __launch_bounds__(512, 2) mk_fwd(Args a) {
    extern __shared__ __attribute__((aligned(16))) unsigned char lds_raw[];
    LAS unsigned char* lds = (LAS unsigned char*)lds_raw;
    const int wave0 = __builtin_amdgcn_readfirstlane(threadIdx.x >> 6);
    const int G = gridDim.x, bx = blockIdx.x;
    const int vcu = (G % 8 == 0) ? (bx % 8) * (G / 8) + bx / 8 : bx;
    const int NGW = G * 8, NGT = G * 512;
#define PH_VARS const int tid = mk_tid(wave0); const int lane = tid & 63, wave = __builtin_amdgcn_readfirstlane(tid >> 6); const int gw = vcu * 8 + wave, gtid = vcu * 512 + tid; (void)lane; (void)gw; (void)gtid;
    { const int tid = mk_tid(wave0);
    for (int u = tid; u < (LDS_BYTES - LDSCTL_OFF) / 4; u += 512) ((LAS unsigned*)(lds + LDSCTL_OFF))[u] = 0u;
    __syncthreads();
    if (tid == 0) {
        LAS unsigned long long* tab = (LAS unsigned long long*)(lds + TAB_OFF);
#define TAB_SET(i) tab[i] = (unsigned long long)(uintptr_t)a.in[i]
        TAB_SET(0); TAB_SET(1); TAB_SET(2); TAB_SET(3); TAB_SET(4); TAB_SET(5); TAB_SET(6); TAB_SET(7); TAB_SET(8); TAB_SET(9); TAB_SET(10); TAB_SET(11); TAB_SET(12); TAB_SET(13); TAB_SET(14); TAB_SET(15);
        TAB_SET(16); TAB_SET(17); TAB_SET(18); TAB_SET(19); TAB_SET(20); TAB_SET(21); TAB_SET(22); TAB_SET(23); TAB_SET(24); TAB_SET(25); TAB_SET(26); TAB_SET(27); TAB_SET(28); TAB_SET(29); TAB_SET(30); TAB_SET(31);
#undef TAB_SET
    }
    __syncthreads(); }
    volatile LAS unsigned* MISC = (volatile LAS unsigned*)(lds + LDSCTL_OFF);
    if (mk_tid(wave0) == 0) __hip_atomic_store((unsigned*)(a.ws + WS_CTL) + XCCTAB_WORD + blockIdx.x, xb_xcc_id() + 1u, __ATOMIC_RELAXED, __HIP_MEMORY_SCOPE_AGENT);
    XcdBarrier bar; bar.bar = (unsigned*)(a.ws + WS_CTL) + 1024; bar.x = 0; bar.st = nullptr;
#if !MK_PER_PHASE
    bar = xcd_barrier_post((unsigned*)(a.ws + WS_CTL) + 1024, MISC + 8, mk_tid(wave0));
#define GRID_BAR() xcd_barrier(bar, mk_tid(wave0))
#else
#define GRID_BAR() do {} while (0)
#endif
#if MK_PER_PHASE
    const int lo = a.ph_lo, hi = a.ph_hi;
#else
    constexpr int lo = 0, hi = NPHASES;
#endif
#ifndef PHMASK
#define PHMASK 0xFFFFFFFFu
#endif
#ifndef SPIN_MASK
#define SPIN_MASK 0u
#endif
    unsigned long long t_prev = 0; unsigned long long t_acc = 0;
    if (SPIN_MASK) t_prev = __builtin_amdgcn_s_memrealtime();
#define STAMP(k) do { if (SPIN_MASK) { const unsigned long long t_now = __builtin_amdgcn_s_memrealtime(); if ((SPIN_MASK >> ((k) < 2 ? (k) : 2 + (((k) - 2) & 7))) & 1u) t_acc += t_now - t_prev; t_prev = t_now; } } while (0)
#define SUBSTAMP(bit) do { if (SPIN_MASK) { const unsigned long long t_now = __builtin_amdgcn_s_memrealtime(); if ((SPIN_MASK >> (bit)) & 1u) t_acc += t_now - t_prev; t_prev = t_now; } } while (0)
#define IN(k) (((PHMASK >> ((k) < 2 ? (k) : 2 + (((k) - 2) & 7))) & 1u) && lo <= (k) && (k) < hi)
#define SEAM(k) do { if (lo <= (k) && (k) + 1 < hi) GRID_BAR(); STAMP(k); } while (0)

    if (IN(0)) {
        PH_VARS
        unsigned char* ws = launder(a.ws);
        float* MOD = (float*)(ws + WS_MOD);
        LAS float* vec = (LAS float*)(lds + 0);
        LAS float* red = (LAS float*)(lds + 12288);
        { const float* cctx = inp(lds, I_CCTX); const float* cc = inp(lds, I_C);
          for (int k = tid; k < 3072; k += 512) { const int j = k >> 10, kk = k & 1023; const float x = j == 0 ? cctx[kk] : cc[(j - 1) * 1024 + kk]; vec[k] = x * sigmoidf_(x); } }
        __syncthreads();
        { const float* modw = inp(lds, I_MODW); const float* modb = inp(lds, I_MODB);
          for (int it = vcu; it < 192; it += G) { const int l = it / 96, n0 = 64 * (it % 96);
            gemv3_item(modw + (size_t)l * 1024 * 6144, 6144, 6144, n0, vec, red, MOD + (l * 3 + 0) * 6144, MOD + (l * 3 + 1) * 6144, MOD + (l * 3 + 2) * 6144, modb + l * 6144, wave, lane); } }
        __syncthreads();
        convert_layer(lds, ws, 0, 0, 1 << 30, true, gw, NGW, gtid, NGT, lane, wave);
        float* cosD = (float*)(ws + WS_TAB); float* sinD = cosD + 1024; float* cosM = cosD + 2048; float* sinM = cosD + 2560;
        for (int i = gtid; i < 1024 + 512; i += NGT) {
            if (i < 1024) { const int pos = i >> 4, f = i & 15; const float inv = powf(10000.0f, -(float)f / 16.0f), ang = (float)pos * inv; cosD[i] = cosf(ang); sinD[i] = sinf(ang); }
            else { const int k = i - 1024, pos = k >> 3, f = k & 7; const float inv = powf(10000.0f, -(float)f / 8.0f), ang = (float)pos * inv; cosM[k] = cosf(ang); sinM[k] = sinf(ang); }
        }
    }
    SEAM(0);
    if (IN(1)) {
        PH_VARS
        unsigned char* ws = launder(a.ws);
        float* MOD = (float*)(ws + WS_MOD); float* BIAS1 = (float*)(ws + WS_BIAS1); float* BIAS2 = (float*)(ws + WS_BIAS2);
        bf16_t* XN = (bf16_t*)(ws + WS_XN); float* XSS = (float*)(ws + WS_XSS);
        LAS float* vec = (LAS float*)(lds + 0); LAS float* red = (LAS float*)(lds + 12288);
        { const float* wup = inp(lds, I_WUP); const float* win = inp(lds, I_WIN);
        for (int it = vcu; it < 326; it += G) {
            const int l = it / 163, r = it % 163; const bool isup = r >= 99; const int n0 = 64 * (isup ? r - 99 : r);
            __syncthreads();
            for (int k = tid; k < 3072; k += 512) { const int j = k >> 10, kk = k & 1023; vec[k] = MOD[(l * 3 + j) * 6144 + (isup ? 3072 : 0) + kk]; }
            __syncthreads();
            if (isup) gemv3_item(wup + (size_t)l * 1024 * 4096, 4096, 4096, n0, vec, red, BIAS2 + (l * 3 + 0) * 4096, BIAS2 + (l * 3 + 1) * 4096, BIAS2 + (l * 3 + 2) * 4096, nullptr, wave, lane);
            else gemv3_item(win + (size_t)l * 1024 * NIN, NIN, NIN, n0, vec, red, BIAS1 + (l * 3 + 0) * NIN, BIAS1 + (l * 3 + 1) * NIN, BIAS1 + (l * 3 + 2) * NIN, nullptr, wave, lane);
        } }
        { const float* xp = inp(lds, I_XP); const float* xs = inp(lds, I_XS); const float* g = inp(lds, I_N1G);
        for (int rb = gw; rb < MROWS; rb += 4 * NGW) {
            f32x4 x[4][4];
#pragma unroll
            for (int q = 0; q < 4; ++q) { const int row = rb + q * NGW; if (row < MROWS) { const float* xr = row < 4096 ? xp + (size_t)row * 1024 : xs + (size_t)(row - 4096) * 1024;
#pragma unroll
                for (int j = 0; j < 4; ++j) x[q][j] = *(const f32x4*)(xr + 256 * j + 4 * lane); } }
#pragma unroll
            for (int q = 0; q < 4; ++q) { const int row = rb + q * NGW; if (row < MROWS) {
                const int cond = row < 4096 ? 0 : 1 + ((row - 4096) >> 11);
                const float* sc = MOD + (0 * 3 + cond) * 6144 + 1024;
                float ss = 0.f;
#pragma unroll
                for (int j = 0; j < 4; ++j) { const int col = 256 * j + 4 * lane; ss += sum4(x[q][j] * x[q][j]);
                    const f32x4 y = x[q][j] * *(const f32x4*)(g + col) * (*(const f32x4*)(sc + col) + 1.0f); u32x2 w; w.x = pk2(y[0], y[1]); w.y = pk2(y[2], y[3]); *(u32x2*)(XN + (size_t)row * 1024 + col) = w; }
                ss = wave_sum(ss);
                if (lane < 16) XSS[(size_t)row * 16 + lane] = lane == 0 ? ss : 0.f;
            } }
        } }
    }
    SEAM(1);

    for (int l = 0; l < 2; ++l) {
        const int P = 2 + 8 * l;
        if (IN(P + 0)) {
            unsigned char* ws = launder(a.ws);
            pg8::Gemm g{(const bf16_t*)(ws + WS_XN), (const bf16_t*)(ws + WS_BT1), MROWS, 6144, 1024}; pg8::StaticOrder S; S.init(MROWS, 6144, G, launder_s(bx));
            EpiIn E{ws, a.out, inp(lds, I_DQN) + l * 64, inp(lds, I_DKN) + l * 64, l, 0};
            pg8::gemm_phase<EpiIn, true>(lds, g, S, E, wave0);
        }
        SEAM(P + 0);
        if (IN(P + 1)) {
            { unsigned char* ws = launder(a.ws);
              pg8::Gemm g{(const bf16_t*)(ws + WS_XN), (const bf16_t*)(ws + WS_BT1) + (size_t)6144 * 1024, MROWS, 256, 1024}; pg8::StaticOrder S; S.init(MROWS, 256, G, (launder_s(bx) + 32) % G);
              EpiIn E{ws, a.out, inp(lds, I_DQN) + l * 64, inp(lds, I_DKN) + l * 64, l, 24};
              pg8::gemm_phase<EpiIn, false>(lds, g, S, E, wave0); }
#if !defined(P2SUB) || P2SUB == 0
            { unsigned char* ws = launder(a.ws);
              pg8::Gemm g{(const bf16_t*)(ws + WS_CQ), (const bf16_t*)(ws + WS_BT2A), MROWS, 768, 384}; pg8::StaticOrder S; S.init(MROWS, 768, G, launder_s(bx));
              EpiQM E{ws, inp(lds, I_MQN) + l * 96};
              pg8::gemm_phase<EpiQM, false>(lds, g, S, E, wave0); }
            SUBSTAMP(10);
#endif
#if !defined(P2SUB) || P2SUB == 1
            { unsigned char* ws = launder(a.ws);
              pg8::Gemm g{(const bf16_t*)(ws + WS_CKVA), (const bf16_t*)(ws + WS_BT2B), KROWS, 1024, 256}; pg8::StaticOrder S; S.init(KROWS, 1024, G, (launder_s(bx) + 168) % G);
              EpiKV E{ws, a.out, inp(lds, I_MKN) + l * 96, inp(lds, I_KVAN) + l * 256, l};
              pg8::gemm_phase<EpiKV, false>(lds, g, S, E, wave0); }
            SUBSTAMP(11);
#endif
#if !defined(P2SUB) || P2SUB == 2
            { unsigned char* ws = launder(a.ws);
              const float* dw = inp(lds, I_CDW) + (size_t)l * 31 * 512; const float* cb = inp(lds, I_CB) + l * 512; const float* cg = inp(lds, I_CNG) + l * 512;
              if (bx < 224) for (int it = bx; it < 256; it += 224) conv_item(lds, (const bf16_t*)(ws + WS_U), dw, cb, cg, (bf16_t*)(ws + WS_ACAT), it, wave0); }
            SUBSTAMP(12);
#endif
        }
        SEAM(P + 1);
        if (IN(P + 2)) {
            PH_VARS
            unsigned char* ws = launder(a.ws);
            const bf16_t* QD = (const bf16_t*)(ws + WS_QD); const bf16_t* KD = (const bf16_t*)(ws + WS_KD); const bf16_t* VD = (const bf16_t*)(ws + WS_VD);
            const bf16_t* QM = (const bf16_t*)(ws + WS_QM); const bf16_t* KM = (const bf16_t*)(ws + WS_KM); const bf16_t* VM = (const bf16_t*)(ws + WS_VM);
            const float* QSS = (const float*)(ws + WS_QSS); const float* CQP = (const float*)(ws + WS_CQP); bf16_t* ACAT = (bf16_t*)(ws + WS_ACAT);
            const float lam_init = l == 0 ? 0.2f : 0.35550906759f;
            float lam;
            { const float* lp = inp(lds, I_DLAM) + l * 256; float s1 = 0.f, s2 = 0.f;
#pragma unroll 8
              for (int i = 0; i < 64; ++i) { s1 += lp[i] * lp[64 + i]; s2 += lp[128 + i] * lp[192 + i]; }
              lam = __expf(s1) - __expf(s2) + lam_init; }
            const float* subln = inp(lds, I_DSUB) + l * 128;
            for (int c = vcu; c < 256; c += G) {
                if (c < 128) {
                    { const int b = c >> 6, h = (c >> 4) & 3, qb = c & 15; diff_unit(lds, QD, KD, VD, ACAT, 4096 + 2048 * b + 128 * qb, 4096 + 2304 * b, 36, h, lam, 1.0f - lam_init, subln, (qb * 36) >> 4, wave0); }
                    SUBSTAMP(13);
                    { const int b = c >> 3, h = c & 7; mla_unit(lds, QM, QSS, CQP, KM, VM, ACAT, 256 * b, 256 * b, 4, h, 0, wave0); }
                    SUBSTAMP(14);
                } else {
                    const int i = c - 128;
                    { const int b = i >> 6, h = (i >> 3) & 7, qb = i & 7; mla_unit(lds, QM, QSS, CQP, KM, VM, ACAT, 4096 + 2048 * b + 256 * qb, 4096 + 2304 * b, 36, h, (qb * 36) >> 3, wave0); }
                    SUBSTAMP(15);
                    { const int b = i >> 3, h = (i >> 1) & 3, qb = i & 1; diff_unit(lds, QD, KD, VD, ACAT, 256 * b + 128 * qb, 256 * b, 4, h, lam, 1.0f - lam_init, subln, 2 * qb, wave0); }
                }
            }
        }
        SEAM(P + 2);
        if (IN(P + 3)) {
            unsigned char* ws = launder(a.ws);
            pg8::Gemm g{(const bf16_t*)(ws + WS_ACAT), (const bf16_t*)(ws + (l == 0 ? WS_BT4 : WS_BT4B)), MROWS, 1024, 1536}; pg8::StaticOrder S; S.init(MROWS, 1024, G, launder_s(bx), 1);
            EpiMerge E{ws, 8192 + (l * 3 + 0) * 1024};
            pg8::gemm_phase<EpiMerge, false>(lds, g, S, E, wave0);
            if (l == 0 && bx >= 128) { PH_VARS convert_layer(lds, ws, 1, 0, 4424, true, (bx - 128) * 8 + wave, 1024, (bx - 128) * 512 + tid, 65536, lane, wave); }
        }
        SEAM(P + 3);
        if (IN(P + 4)) {
            unsigned char* ws = launder(a.ws);
            pg8::Gemm g{(const bf16_t*)(ws + WS_MG), (const bf16_t*)(ws + (l == 0 ? WS_BT5 : WS_BT5B)), MROWS, 1024, 1024}; pg8::StaticOrder S; S.init(MROWS, 1024, G, launder_s(bx), 1);
            EpiRes E{l == 0 ? inp(lds, I_XP) : a.out, l == 0 ? inp(lds, I_XS) : a.out + (size_t)4096 * 1024, a.out, ws, l * 3 * 6144 + 2048, inp(lds, I_N2G) + l * 1024, l * 3 * 6144 + 4096, 8192 + (l * 3 + 1) * 1024};
            pg8::gemm_phase<EpiRes, false>(lds, g, S, E, wave0);
            if (l == 0 && bx >= 128) { PH_VARS convert_layer(lds, ws, 1, 4424, 1 << 30, false, (bx - 128) * 8 + wave, 1024, (bx - 128) * 512 + tid, 65536, lane, wave); }
        }
        SEAM(P + 4);
        if (IN(P + 5)) {
            unsigned char* ws = launder(a.ws);
            pg8::Gemm g{(const bf16_t*)(ws + WS_XN), (const bf16_t*)(ws + (l == 0 ? WS_BT6 : WS_BT6B)), MROWS, 4096, 1024}; pg8::StaticOrder S; S.init(MROWS, 4096, G, launder_s(bx));
            EpiUp E{ws, l};
            pg8::gemm_phase<EpiUp, true>(lds, g, S, E, wave0);
        }
        SEAM(P + 5);
        if (IN(P + 6)) {
            unsigned char* ws = launder(a.ws);
            pg8::Gemm g{(const bf16_t*)(ws + WS_R1), (const bf16_t*)(ws + (l == 0 ? WS_BT7 : WS_BT7B)), MROWS, 1024, 4096}; pg8::StaticOrder S; S.init(MROWS, 1024, G, launder_s(bx), 2);
            EpiRes E{a.out, a.out + (size_t)4096 * 1024, a.out, ws, l * 3 * 6144 + 5120, l == 0 ? inp(lds, I_N1G) + 1024 : nullptr, 3 * 6144 + 1024, 8192 + (l * 3 + 2) * 1024};
            pg8::gemm_phase<EpiRes, false>(lds, g, S, E, wave0);
        }
        if (l == 0) { if (lo <= P + 6 && P + 8 < hi) GRID_BAR(); STAMP(P + 6); }
    }
    STAMP(16);
    if (SPIN_MASK) { const unsigned long long t0 = __builtin_amdgcn_s_memrealtime(); while (__builtin_amdgcn_s_memrealtime() - t0 < t_acc) __builtin_amdgcn_s_sleep(8); }
#undef IN
#undef SEAM
}

extern "C" void kernel_launch(void* const* d_in, const int* in_sizes, int n_in, void* d_out, int out_size, void* d_ws, size_t ws_size, hipStream_t stream) {
    static int grid = 0;
    if (grid == 0) {
        if (n_in != 32 || out_size != 19136512 || ws_size < WS_END) { fprintf(stderr, "kernel_launch: unexpected shapes (n_in %d out %d ws %zu)\n", n_in, out_size, ws_size); grid = -1; return; }
        int dev = 0, cus = 0;
        if (hipGetDevice(&dev) != hipSuccess || hipDeviceGetAttribute(&cus, hipDeviceAttributeMultiprocessorCount, dev) != hipSuccess) { grid = -1; return; }
        if (hipFuncSetAttribute((const void*)mk_fwd, hipFuncAttributeMaxDynamicSharedMemorySize, LDS_BYTES) != hipSuccess) { fprintf(stderr, "kernel_launch: hipFuncSetAttribute failed\n"); grid = -1; return; }
        int per_cu = 0;
        if (hipOccupancyMaxActiveBlocksPerMultiprocessor(&per_cu, (const void*)mk_fwd, 512, LDS_BYTES) != hipSuccess || per_cu < 1) fprintf(stderr, "kernel_launch: occupancy query reports %d\n", per_cu);
        (void)hipGetLastError();
        grid = cus;
    }
    if (grid < 0) return;
    (void)hipMemsetAsync((char*)d_ws + WS_CTL, 0, CTL_ZERO_BYTES, stream);
    Args a{};
    for (int i = 0; i < 32; ++i) a.in[i] = (const float*)d_in[i];
    a.out = (float*)d_out; a.ws = (unsigned char*)d_ws;
#if MK_PER_PHASE
    for (int p = 0; p < NPHASES; ++p) { a.ph_lo = p; a.ph_hi = p + 1; hipLaunchKernelGGL(mk_fwd, dim3(grid), dim3(512), LDS_BYTES, stream, a); }
#else
    a.ph_lo = 0; a.ph_hi = NPHASES;
    hipLaunchKernelGGL(mk_fwd, dim3(grid), dim3(512), LDS_BYTES, stream, a);
#endif
}
```

```cpp
#include <hip/hip_runtime.h>
#include <cstdio>
#include <cstdint>

#define LAS __attribute__((address_space(3)))
#define GAS __attribute__((address_space(1)))
typedef unsigned short bf16_t;
typedef short bf16x8 __attribute__((ext_vector_type(8)));
typedef short s16x4 __attribute__((ext_vector_type(4)));
typedef float f32x4 __attribute__((ext_vector_type(4)));
typedef float f32x16 __attribute__((ext_vector_type(16)));
typedef unsigned u32x4 __attribute__((ext_vector_type(4)));
typedef unsigned u32x2 __attribute__((ext_vector_type(2)));
typedef float f32x2_t __attribute__((ext_vector_type(2)));
typedef __bf16 bf16x2_t __attribute__((ext_vector_type(2)));
typedef short v4i16_t __attribute__((ext_vector_type(4)));

#ifndef MK_PER_PHASE
#define MK_PER_PHASE 0
#endif

constexpr int DM = 1024, MROWS = 8192, MPROMPT = 4096, KROWS = 8704, NIN = 6304, NINP = 6400, DFF = 4096;
constexpr float EPSF = 1e-6f;
constexpr float LOG2E = 1.4426950408889634f;
constexpr size_t OUT_Y = 0, OUT_DK = 8388608, OUT_DV = 12582912, OUT_CKV = 16777216, OUT_KPE = 18874368;

constexpr size_t al256(size_t x) { return (x + 255) & ~(size_t)255; }
constexpr size_t WS_CTL = 0, CTL_ZERO_BYTES = 65536;
constexpr size_t WS_BT1 = 65536;
constexpr size_t WS_BT2A = WS_BT1 + (size_t)NINP * 1024 * 2;
constexpr size_t WS_BT2B = WS_BT2A + (size_t)768 * 384 * 2;
constexpr size_t WS_BT4 = WS_BT2B + (size_t)1024 * 256 * 2;
constexpr size_t WS_BT5 = WS_BT4 + (size_t)1024 * 1536 * 2;
constexpr size_t WS_BT6 = WS_BT5 + (size_t)1024 * 1024 * 2;
constexpr size_t WS_BT7 = WS_BT6 + (size_t)4096 * 1024 * 2;
constexpr size_t WS_MOD = WS_BT7 + (size_t)1024 * 4096 * 2;
constexpr size_t WS_BIAS1 = WS_MOD + al256(2 * 3 * 6144 * 4);
constexpr size_t WS_BIAS2 = WS_BIAS1 + al256(2 * 3 * NIN * 4);
constexpr size_t WS_TAB = WS_BIAS2 + al256(2 * 3 * 4096 * 4);
constexpr size_t WS_XN = WS_TAB + 16384;
constexpr size_t WS_XSS = WS_XN + (size_t)MROWS * 1024 * 2;
constexpr size_t WS_U = WS_XSS + (size_t)MROWS * 16 * 4;
constexpr size_t WS_QD = WS_U + (size_t)MROWS * 512 * 2;
constexpr size_t WS_KD = WS_QD + (size_t)MROWS * 512 * 2;
constexpr size_t WS_VD = WS_KD + (size_t)KROWS * 512 * 2;
constexpr size_t WS_CQ = WS_VD + (size_t)KROWS * 512 * 2;
constexpr size_t WS_CQP = WS_CQ + (size_t)MROWS * 384 * 2;
constexpr size_t WS_CKVA = WS_CQP + (size_t)MROWS * 8 * 4;
constexpr size_t WS_CKVP = WS_CKVA + (size_t)KROWS * 256 * 2;
constexpr size_t WS_KPER = WS_CKVP + (size_t)MROWS * 4 * 4;
constexpr size_t WS_KPESS = WS_KPER + (size_t)KROWS * 32 * 4;
constexpr size_t WS_QM = WS_KPESS + al256(KROWS * 4);
constexpr size_t WS_QSS = WS_QM + (size_t)MROWS * 768 * 2;
constexpr size_t WS_KM = WS_QSS + (size_t)MROWS * 24 * 4;
constexpr size_t WS_VM = WS_KM + (size_t)KROWS * 768 * 2;
constexpr size_t WS_ACAT = WS_VM + (size_t)KROWS * 512 * 2;
constexpr size_t WS_MG = WS_ACAT + (size_t)MROWS * 1536 * 2;
constexpr size_t WS_R1 = WS_MG + (size_t)MROWS * 1024 * 2;
constexpr size_t WS_BT4B = WS_R1 + (size_t)MROWS * 4096 * 2;
constexpr size_t WS_BT5B = WS_BT4B + (size_t)1024 * 1536 * 2;
constexpr size_t WS_BT6B = WS_BT5B + (size_t)1024 * 1024 * 2;
constexpr size_t WS_BT7B = WS_BT6B + (size_t)4096 * 1024 * 2;
constexpr size_t WS_END = WS_BT7B + (size_t)1024 * 4096 * 2;
static_assert(WS_END <= 268435456, "d_ws map exceeds 256 MiB");
static_assert(WS_QM + 67108864 <= WS_R1, "split-K slab must end before the G/H region");

constexpr int RING_BYTES = 131072, LDSCTL_OFF = RING_BYTES, LDS_BYTES = 147456;

__device__ __forceinline__ unsigned pk2(float lo, float hi) { f32x2_t v = {lo, hi}; bf16x2_t b = __builtin_convertvector(v, bf16x2_t); return __builtin_bit_cast(unsigned, b); }
__device__ __forceinline__ float bflo(unsigned w) { return __uint_as_float(w << 16); }
__device__ __forceinline__ float bfhi(unsigned w) { return __uint_as_float(w & 0xffff0000u); }
__device__ __forceinline__ float sigmoidf_(float x) { return __builtin_amdgcn_rcpf(1.0f + __expf(-x)); }
__device__ __forceinline__ float wave_sum(float v) {
#pragma unroll
    for (int o = 1; o < 64; o <<= 1) v += __shfl_xor(v, o);
    return v;
}
__device__ __forceinline__ float sum4(f32x4 a) { return (a[0] + a[1]) + (a[2] + a[3]); }
__device__ __forceinline__ float rinv16(const float* p, float invn) {
    const f32x4 a = ((const f32x4*)p)[0], b = ((const f32x4*)p)[1], c = ((const f32x4*)p)[2], d = ((const f32x4*)p)[3];
    return rsqrtf(((sum4(a) + sum4(b)) + (sum4(c) + sum4(d))) * invn + EPSF);
}
__device__ __forceinline__ void rinv8(const float* xss, int rbase, int fq, float (&ri)[8]) {
    f32x4 p[8];
#pragma unroll
    for (int j = 0; j < 8; ++j) p[j] = *(const f32x4*)(xss + (size_t)(rbase + (j >> 2) * 128 + (j & 3) * 16) * 16 + 4 * fq);
#pragma unroll
    for (int j = 0; j < 8; ++j) { float sacc = sum4(p[j]); sacc += __shfl_xor(sacc, 16); sacc += __shfl_xor(sacc, 32); ri[j] = rsqrtf(sacc * (1.0f / 1024.0f) + EPSF); }
}
__device__ __forceinline__ int keyrow(int row) {
    return row < 4096 ? row : (row < 8192 ? row + 256 * (((row - 4096) >> 11) + 1) : 4096 + ((row - 8192) >> 8) * 2304 + ((row - 8192) & 255));
}
__device__ __forceinline__ int crow(int r, int hi) { return (r & 3) + 8 * (r >> 2) + 4 * hi; }
__device__ __forceinline__ u32x4 gld16(const void* p) { return *(const GAS u32x4*)(unsigned long long)(uintptr_t)p; }
__device__ __forceinline__ f32x4 gldf4(const void* p) { return *(const GAS f32x4*)(unsigned long long)(uintptr_t)p; }
#define LDS_WAIT() asm volatile("s_waitcnt lgkmcnt(0)" ::: "memory")
#define MEMFENCE() asm volatile("" ::: "memory")
template <class T> __device__ __forceinline__ T* launder(T* p) { unsigned long long v = (unsigned long long)(uintptr_t)p; asm volatile("" : "+s"(v)); return (T*)(GAS T*)v; }
__device__ __forceinline__ int launder_s(int v) { asm volatile("" : "+s"(v)); return v; }
__device__ __forceinline__ int mk_tid(int wave0) {
    int lane_;
    asm volatile("v_mbcnt_lo_u32_b32 %0, -1, 0\n\tv_mbcnt_hi_u32_b32 %0, -1, %0" : "=v"(lane_));
    return wave0 * 64 + lane_;
}
#define VM_WAIT() asm volatile("s_waitcnt vmcnt(0)" ::: "memory")

namespace pg8 {
constexpr int BM = 256, BK = 64, HALF = 128, HTB = HALF * BK * 2, STAGE_BYTES = 8 * HTB, NXCD = 8, WGM = 8;
__host__ __device__ __forceinline__ int lds_byte(int r, int c) { const int st = (r >> 4) * 2 + (c >> 5), rr = r & 15, cc = c & 31, ob = rr * 64 + cc * 2; return st * 1024 + (ob ^ (((ob >> 9) & 1) << 5)); }
__host__ __device__ __forceinline__ void stage_rc(int b, int& R, int& C) { const int st = b / 1024, sb = b % 1024, swz = sb ^ (((sb >> 9) & 1) << 5); R = (st >> 1) * 16 + swz / 64; C = (st & 1) * 32 + (swz % 64) / 2; }
struct Unit { int pm, pn, ks; };
struct Gemm { const bf16_t* A; const bf16_t* Bt; int M, N, K; };
struct StaticOrder {
    int nM, nN, nwg, G, c, nsplit;
    __host__ __device__ void init(int M, int N, int G_, int c_, int nsplit_ = 1) { nM = M / BM; nN = N / BM; nwg = nM * nN; G = G_; c = c_; nsplit = nsplit_; }
    __host__ __device__ bool next(int i, Unit& u) const {
        const long L0 = (long)i * G + c; if (L0 >= (long)nwg * nsplit) return false;
        long L = L0; u.ks = 0;
        if (nsplit == 2) { u.ks = (int)((L0 >> 3) & 1); L = (L0 & 7) + 8 * (L0 >> 4); }
        int wgid = (int)L; { const int q = nwg / NXCD, r = nwg % NXCD, xcd = wgid % NXCD, off = wgid / NXCD; wgid = (xcd < r ? xcd * (q + 1) : r * (q + 1) + (xcd - r) * q) + off; }
        const int nig = WGM * nN, gid = wgid / nig, fm = gid * WGM, gsz = (nM - fm) < WGM ? (nM - fm) : WGM;
        u.pm = fm + ((wgid % nig) % gsz); u.pn = (wgid % nig) / gsz; return true;
    }
};
template <class Epi, bool ALIGN_EPI>
__device__ __forceinline__ void gemm_phase(LAS unsigned char* lds, const Gemm g, const StaticOrder& S, const Epi& E, int wave0) {
    const int tid = mk_tid(wave0);
    const int wid = __builtin_amdgcn_readfirstlane(tid >> 6), lane = tid & 63, wr = wid >> 2, wc = wid & 3, fr = lane & 15, fq = lane >> 4;
    const int K = g.K, nt = K / BK / S.nsplit;
    const size_t ksoff = (size_t)(K / S.nsplit) * 2;
    unsigned voffA[2];
#pragma unroll
    for (int i = 0; i < 2; ++i) { int R, C; stage_rc(tid * 16 + i * 8192, R, C); voffA[i] = (unsigned)(R * K + C) * 2u; }
    const size_t kstep = (size_t)(BK * 2);
    const size_t hstep = (size_t)HALF * K * 2;
    const size_t tstep = 2 * hstep;
    const unsigned ldsw = (unsigned)wid * 1024u;
    const int aoff = lds_byte(wr * 64 + fr, fq * 8), boff = lds_byte(wc * 32 + fr, fq * 8);
#define PG8_SA(b, h) (((b) * 2 + (h)) * HTB)
#define PG8_SB(b, h) ((4 + (b) * 2 + (h)) * HTB)
#define PG8_STAGE(bufoff, gbase) do { _Pragma("unroll") for (int _i = 0; _i < 2; ++_i) \
        __builtin_amdgcn_global_load_lds((const unsigned*)((const char*)(gbase) + voffA[_i]), (LAS unsigned*)(lds + (bufoff) + ldsw + _i * 8192), 16, 0, 0); } while (0)
#define PG8_LDA(dst, b, h) do { _Pragma("unroll") for (int m = 0; m < 4; ++m) _Pragma("unroll") for (int k = 0; k < 2; ++k) dst[m][k] = *(const LAS bf16x8*)(lds + PG8_SA(b, h) + aoff + m * 2048 + k * 1024); } while (0)
#define PG8_LDB(dst, b, h) do { _Pragma("unroll") for (int n = 0; n < 2; ++n) _Pragma("unroll") for (int k = 0; k < 2; ++k) dst[n][k] = *(const LAS bf16x8*)(lds + PG8_SB(b, h) + boff + n * 2048 + k * 1024); } while (0)
#define PG8_MMA(ai, bj, At, Bt) do { __builtin_amdgcn_s_setprio(1); _Pragma("unroll") for (int m = 0; m < 4; ++m) _Pragma("unroll") for (int n = 0; n < 2; ++n) _Pragma("unroll") for (int k = 0; k < 2; ++k) \
        acc[ai][bj][m][n] = __builtin_amdgcn_mfma_f32_16x16x32_bf16(Bt[n][k], At[m][k], acc[ai][bj][m][n], 0, 0, 0); __builtin_amdgcn_s_setprio(0); } while (0)
#define PG8_WAIT_V(n) asm volatile("s_waitcnt vmcnt(" #n ")" ::: "memory")
#define PG8_WAIT_L(n) asm volatile("s_waitcnt lgkmcnt(" #n ")" ::: "memory")
#define PG8_BAR __builtin_amdgcn_s_barrier()
#define PG8_SCHED __builtin_amdgcn_sched_barrier(0)
    Unit cur, nxt; int ui = 0;
    if (!S.next(0, cur)) return;
    f32x4 acc[2][2][4][2];
#pragma unroll
    for (int a = 0; a < 2; ++a)
#pragma unroll
        for (int b = 0; b < 2; ++b)
#pragma unroll
            for (int m = 0; m < 4; ++m)
#pragma unroll
                for (int n = 0; n < 2; ++n) acc[a][b][m][n] = (f32x4){0.f, 0.f, 0.f, 0.f};
    bf16x8 At[4][2], B0[2][2], B1[2][2];
    const char* cA = (const char*)g.A + (size_t)cur.pm * tstep + cur.ks * ksoff; const char* cB = (const char*)g.Bt + (size_t)cur.pn * tstep + cur.ks * ksoff;
    PG8_STAGE(PG8_SB(0, 0), cB); PG8_STAGE(PG8_SB(0, 1), cB + hstep); PG8_STAGE(PG8_SA(0, 0), cA); PG8_STAGE(PG8_SA(0, 1), cA + hstep);
    if (wr == 1) PG8_BAR;
    PG8_WAIT_V(2); PG8_BAR;
    PG8_STAGE(PG8_SB(1, 0), cB + kstep); PG8_STAGE(PG8_SA(1, 0), cA + kstep); PG8_STAGE(PG8_SB(1, 1), cB + hstep + kstep);
    PG8_WAIT_V(6); PG8_BAR;
    for (;;) {
        const bool has_next = S.next(ui + 1, nxt);
        const char* nA = has_next ? (const char*)g.A + (size_t)nxt.pm * tstep + nxt.ks * ksoff : cA; const char* nB = has_next ? (const char*)g.Bt + (size_t)nxt.pn * tstep + nxt.ks * ksoff : cB;
#pragma unroll 1
        for (int t = 0; t < nt; t += 2) {
            if constexpr (Epi::HOOK) { const int tg = cur.ks * nt + t; if (tg == 8 || tg == 16) E.hook(acc, cur, tg, wr, wc, fr, fq); }
            const bool last = (t == nt - 2);
            const char* a1 = cA + (size_t)(t + 1) * kstep;
            const char* a2 = last ? nA : cA + (size_t)(t + 2) * kstep; const char* b2 = last ? nB : cB + (size_t)(t + 2) * kstep;
            const char* a3 = a2 + kstep; const char* b3 = b2 + kstep;
            PG8_LDB(B0, 0, 0); PG8_LDB(B1, 0, 1); PG8_SCHED; PG8_LDA(At, 0, 0); PG8_STAGE(PG8_SA(1, 1), a1 + hstep);
            PG8_WAIT_V(8); PG8_WAIT_L(0); PG8_BAR; PG8_MMA(0, 0, At, B0); PG8_MMA(0, 1, At, B1); PG8_BAR; PG8_SCHED;
            PG8_LDA(At, 0, 1); PG8_STAGE(PG8_SB(0, 0), b2); PG8_STAGE(PG8_SB(0, 1), b2 + hstep); PG8_STAGE(PG8_SA(0, 0), a2);
            PG8_WAIT_V(8); PG8_WAIT_L(0); PG8_BAR; PG8_MMA(1, 0, At, B0); PG8_MMA(1, 1, At, B1); PG8_BAR; PG8_SCHED;
            PG8_LDB(B0, 1, 0); PG8_LDB(B1, 1, 1); PG8_SCHED; PG8_LDA(At, 1, 0); PG8_STAGE(PG8_SA(0, 1), a2 + hstep);
            PG8_WAIT_V(8); PG8_WAIT_L(0); PG8_BAR; PG8_MMA(0, 0, At, B0); PG8_MMA(0, 1, At, B1); PG8_BAR; PG8_SCHED;
            PG8_LDA(At, 1, 1); PG8_STAGE(PG8_SB(1, 0), b3); PG8_STAGE(PG8_SB(1, 1), b3 + hstep); PG8_STAGE(PG8_SA(1, 0), a3);
            PG8_WAIT_V(8); PG8_WAIT_L(0); PG8_BAR; PG8_MMA(1, 0, At, B0); PG8_MMA(1, 1, At, B1); PG8_BAR; PG8_SCHED;
        }
        if constexpr (ALIGN_EPI) { if (wr == 0) PG8_BAR; }
        if constexpr (Epi::SPLIT) {
            E.pre(acc, cur, S.nsplit, wr, wc, fr, fq);
            bool run_epi = true;
            if (S.nsplit == 2) run_epi = E.exchange(acc, cur.pm * S.nN + cur.pn, cur.ks, wid, lane);
            if (run_epi) E(acc, cur, wr, wc, fr, fq);
        } else E(acc, cur, wr, wc, fr, fq);
        if (!has_next) break;
#pragma unroll
        for (int a = 0; a < 2; ++a)
#pragma unroll
            for (int b = 0; b < 2; ++b)
#pragma unroll
                for (int m = 0; m < 4; ++m)
#pragma unroll
                    for (int n = 0; n < 2; ++n) acc[a][b][m][n] = (f32x4){0.f, 0.f, 0.f, 0.f};
        cur = nxt; cA = nA; cB = nB; ++ui;
        if constexpr (ALIGN_EPI) { if (wr == 1) PG8_BAR; }
    }
    PG8_WAIT_V(0);
    if constexpr (!ALIGN_EPI) { if (wr == 0) PG8_BAR; }
    PG8_BAR;
#undef PG8_SA
#undef PG8_SB
#undef PG8_STAGE
#undef PG8_LDA
#undef PG8_LDB
#undef PG8_MMA
#undef PG8_WAIT_V
#undef PG8_WAIT_L
#undef PG8_BAR
#undef PG8_SCHED
}
}
using pg8::Unit;
typedef f32x4 Acc[2][2][4][2];

#define XCCTAB_WORD 15360
__device__ __forceinline__ bool splitk_exchange(Acc& acc, unsigned char* ws, int cnt_off, int tile, int ks, int wid, int lane) {
    unsigned* ctl = (unsigned*)(ws + WS_CTL);
    const __amdgpu_buffer_rsrc_t rsrc = __builtin_amdgcn_make_buffer_rsrc((void*)(ws + WS_QM), 0, 67108864, 0x00020000);
    const unsigned base = (unsigned)(((ks * 128 + tile) * 8 + wid) * 32) * 1024u + (unsigned)lane * 16u;
    const unsigned obase = (unsigned)((((ks ^ 1) * 128 + tile) * 8 + wid) * 32) * 1024u + (unsigned)lane * 16u;
    const unsigned mine = __hip_atomic_load(ctl + XCCTAB_WORD + blockIdx.x, __ATOMIC_RELAXED, __HIP_MEMORY_SCOPE_AGENT);
    const unsigned theirs = __hip_atomic_load(ctl + XCCTAB_WORD + (blockIdx.x ^ 8u), __ATOMIC_RELAXED, __HIP_MEMORY_SCOPE_AGENT);
    const bool same = __builtin_amdgcn_readfirstlane((int)(mine == theirs && mine != 0u)) != 0;
    if (same) {
#pragma unroll
        for (int ai = 0; ai < 2; ++ai)
#pragma unroll
            for (int bj = 0; bj < 2; ++bj)
#pragma unroll
                for (int m = 0; m < 4; ++m)
#pragma unroll
                    for (int n = 0; n < 2; ++n) { const int q = ((ai * 2 + bj) * 4 + m) * 2 + n; __builtin_amdgcn_raw_buffer_store_b128(__builtin_bit_cast(u32x4, acc[ai][bj][m][n]), rsrc, base + q * 1024, 0, 0); }
    } else {
#pragma unroll
        for (int ai = 0; ai < 2; ++ai)
#pragma unroll
            for (int bj = 0; bj < 2; ++bj)
#pragma unroll
                for (int m = 0; m < 4; ++m)
#pragma unroll
                    for (int n = 0; n < 2; ++n) { const int q = ((ai * 2 + bj) * 4 + m) * 2 + n; __builtin_amdgcn_raw_buffer_store_b128(__builtin_bit_cast(u32x4, acc[ai][bj][m][n]), rsrc, base + q * 1024, 0, 16); }
    }
    asm volatile("s_waitcnt vmcnt(0)" ::: "memory");
    unsigned ticket = 0;
    if (lane == 0) ticket = __hip_atomic_fetch_add(ctl + cnt_off + tile * 8 + wid, 1u, __ATOMIC_RELAXED, __HIP_MEMORY_SCOPE_AGENT);
    ticket = (unsigned)__builtin_amdgcn_readfirstlane((int)ticket);
    if (ticket == 0u) return false;
#pragma unroll
    for (int ai = 0; ai < 2; ++ai) {
        u32x4 v[2][4][2];
#pragma unroll
        for (int bj = 0; bj < 2; ++bj)
#pragma unroll
            for (int m = 0; m < 4; ++m)
#pragma unroll
                for (int n = 0; n < 2; ++n) { const int q = ((ai * 2 + bj) * 4 + m) * 2 + n; v[bj][m][n] = __builtin_amdgcn_raw_buffer_load_b128(rsrc, obase + q * 1024, 0, 16); }
#pragma unroll
        for (int bj = 0; bj < 2; ++bj)
#pragma unroll
            for (int m = 0; m < 4; ++m)
#pragma unroll
                for (int n = 0; n < 2; ++n) { f32x4& d = acc[ai][bj][m][n]; const u32x4 x = v[bj][m][n];
                    d[0] += __uint_as_float(x.x); d[1] += __uint_as_float(x.y); d[2] += __uint_as_float(x.z); d[3] += __uint_as_float(x.w); }
        asm volatile("" : "+v"(acc[ai][0][0][0]), "+v"(acc[ai][0][0][1]), "+v"(acc[ai][0][1][0]), "+v"(acc[ai][0][1][1]), "+v"(acc[ai][0][2][0]), "+v"(acc[ai][0][2][1]), "+v"(acc[ai][0][3][0]), "+v"(acc[ai][0][3][1]),
                          "+v"(acc[ai][1][0][0]), "+v"(acc[ai][1][0][1]), "+v"(acc[ai][1][1][0]), "+v"(acc[ai][1][1][1]), "+v"(acc[ai][1][2][0]), "+v"(acc[ai][1][2][1]), "+v"(acc[ai][1][3][0]), "+v"(acc[ai][1][3][1]) :: "memory");
    }
    return true;
}


struct EpiIn {
    static constexpr bool HOOK = false, SPLIT = false;
    unsigned char* ws0; float* out0; const float* gq; const float* gk; int layer; int pn_off;
    __device__ __forceinline__ void hook(Acc&, const Unit&, int, int, int, int, int) const {}
    __device__ __forceinline__ void operator()(const Acc& acc, const Unit& u, int wr, int wc, int fr, int fq) const {
        unsigned char* ws = launder(ws0); float* out = launder(out0);
        const float* xss = (const float*)(ws + WS_XSS); const float* bias = (const float*)(ws + WS_BIAS1) + (size_t)layer * 3 * NIN;
        const float* cosD = (const float*)(ws + WS_TAB); const float* sinD = cosD + 1024;
        bf16_t* U = (bf16_t*)(ws + WS_U); bf16_t* QD = (bf16_t*)(ws + WS_QD); bf16_t* KD = (bf16_t*)(ws + WS_KD); bf16_t* VD = (bf16_t*)(ws + WS_VD);
        bf16_t* CQ = (bf16_t*)(ws + WS_CQ); bf16_t* CKVA = (bf16_t*)(ws + WS_CKVA); bf16_t* G = (bf16_t*)(ws + WS_R1);
        float* cqpart = (float*)(ws + WS_CQP); float* ckvpart = (float*)(ws + WS_CKVP); float* kperaw = (float*)(ws + WS_KPER); float* kpess = (float*)(ws + WS_KPESS);
        const int pm = u.pm, pn = u.pn + pn_off;
        const int cond = pm < 16 ? 0 : 1 + ((pm - 16) >> 3);
        const bool sample = pm >= 16;
        const int rbase = pm * 256 + wr * 64 + fr;
        const float* bs = bias + cond * NIN;
        float ri8[8]; rinv8(xss, rbase, fq, ri8);
        if (pn < 4) {
            const int ch0 = 128 * pn + 32 * wc + 8 * fq;
            f32x4 ba[2], bg[2];
#pragma unroll
            for (int n = 0; n < 2; ++n) { ba[n] = *(const f32x4*)(bs + ch0 + 4 * n); bg[n] = *(const f32x4*)(bs + 512 + ch0 + 4 * n); }
#pragma unroll
            for (int ai = 0; ai < 2; ++ai)
#pragma unroll
                for (int m = 0; m < 4; ++m) {
                    const int row = rbase + ai * 128 + m * 16; const float ri = ri8[ai * 4 + m];
                    float o[8];
#pragma unroll
                    for (int n = 0; n < 2; ++n)
#pragma unroll
                        for (int i = 0; i < 4; ++i) { const float a = ri * acc[ai][0][m][n][i] + ba[n][i], gte = ri * acc[ai][1][m][n][i] + bg[n][i]; o[4 * n + i] = a * sigmoidf_(gte); }
                    u32x4 w; w.x = pk2(o[0], o[1]); w.y = pk2(o[2], o[3]); w.z = pk2(o[4], o[5]); w.w = pk2(o[6], o[7]);
                    *(u32x4*)(U + (size_t)row * 512 + ch0) = w;
                }
        } else if (pn < 8) {
            const bool isk = pn >= 6; const int grp = 4 * ((pn - 4) & 1) + wc;
            const int ob = (isk ? 1536 : 1024) + 64 * grp; const float* gv = isk ? gk : gq;
            f32x4 bq[2][2];
#pragma unroll
            for (int bj = 0; bj < 2; ++bj)
#pragma unroll
                for (int n = 0; n < 2; ++n) bq[bj][n] = *(const f32x4*)(bs + ob + 32 * bj + 16 * n + 4 * fq);
#pragma unroll
            for (int ai = 0; ai < 2; ++ai)
#pragma unroll
                for (int m = 0; m < 4; ++m) {
                    const int row = rbase + ai * 128 + m * 16; const float ri = ri8[ai * 4 + m];
                    f32x4 v[2][2]; float ss = 0.f;
#pragma unroll
                    for (int bj = 0; bj < 2; ++bj)
#pragma unroll
                        for (int n = 0; n < 2; ++n) { v[bj][n] = acc[ai][bj][m][n] * ri + bq[bj][n]; const f32x4 q2 = v[bj][n] * v[bj][n]; ss += sum4(q2); }
                    ss += __shfl_xor(ss, 16); ss += __shfl_xor(ss, 32);
                    const float rn = rsqrtf(ss * (1.0f / 64.0f) + EPSF);
#pragma unroll
                    for (int bj = 0; bj < 2; ++bj)
#pragma unroll
                        for (int n = 0; n < 2; ++n) v[bj][n] = v[bj][n] * rn * *(const f32x4*)(gv + 32 * bj + 16 * n + 4 * fq);
                    if (isk && !sample) {
                        float* op = out + OUT_DK + ((size_t)(pm * 2 + layer) * 256 + (row & 255)) * 512 + 64 * grp + 4 * fq;
#pragma unroll
                        for (int bj = 0; bj < 2; ++bj)
#pragma unroll
                            for (int n = 0; n < 2; ++n) *(f32x4*)(op + 32 * bj + 16 * n) = v[bj][n];
                    }
                    if (sample) {
                        const int s = row & 2047;
#pragma unroll
                        for (int bj = 0; bj < 2; ++bj) {
                            const int pos = bj == 0 ? (s >> 6) : (s & 63);
                            const f32x4 c4 = *(const f32x4*)(cosD + pos * 16 + 4 * fq), s4 = *(const f32x4*)(sinD + pos * 16 + 4 * fq);
                            const f32x4 x1 = v[bj][0], x2 = v[bj][1];
                            v[bj][0] = x1 * c4 - x2 * s4; v[bj][1] = x2 * c4 + x1 * s4;
                        }
                    }
                    const float qs = isk ? 1.0f : 0.125f * LOG2E;
                    bf16_t* dp = (isk ? KD + (size_t)keyrow(row) * 512 : QD + (size_t)row * 512) + 64 * grp + 4 * fq;
#pragma unroll
                    for (int bj = 0; bj < 2; ++bj)
#pragma unroll
                        for (int n = 0; n < 2; ++n) { const f32x4 x = v[bj][n] * qs; u32x2 w; w.x = pk2(x[0], x[1]); w.y = pk2(x[2], x[3]); *(u32x2*)(dp + 32 * bj + 16 * n) = w; }
                    MEMFENCE();
                }
        } else {
            int obase, kind;
            if (pn < 10) { kind = 0; obase = 2048 + 256 * (pn - 8); }
            else if (pn == 10) { kind = 1; obase = 2560; }
            else if (pn == 11) { kind = 2; obase = 2816; }
            else if (pn == 12) { kind = 3; obase = 2944; }
            else { kind = 4; obase = 3232 + 256 * (pn - 13); }
            const int lc0 = 32 * wc + 8 * fq;
            f32x4 gb0[2], gb1[2];
#pragma unroll
            for (int bj = 0; bj < 2; ++bj) { int oc = obase + 128 * bj + lc0; if (kind == 2 && bj == 1) oc = 3200 + 8 * fq; gb0[bj] = *(const f32x4*)(bs + oc); gb1[bj] = *(const f32x4*)(bs + oc + 4); }
#pragma unroll
            for (int ai = 0; ai < 2; ++ai)
#pragma unroll
                for (int m = 0; m < 4; ++m) {
                    const int row = rbase + ai * 128 + m * 16; const float ri = ri8[ai * 4 + m];
                    float ssw = 0.f;
#pragma unroll
                    for (int bj = 0; bj < 2; ++bj) {
                        int oc = obase + 128 * bj + lc0;
                        bool live = true;
                        if (kind == 2 && bj == 1) { oc = 3200 + 8 * fq; live = (wc == 0); }
                        float o[8];
                        if (live) {
                            const f32x4 b0 = gb0[bj], b1 = gb1[bj];
#pragma unroll
                            for (int i = 0; i < 4; ++i) { o[i] = ri * acc[ai][bj][m][0][i] + b0[i]; o[4 + i] = ri * acc[ai][bj][m][1][i] + b1[i]; }
                        } else {
#pragma unroll
                            for (int i = 0; i < 8; ++i) o[i] = 0.f;
                        }
                        float ssl = 0.f;
#pragma unroll
                        for (int i = 0; i < 8; ++i) ssl += o[i] * o[i];
                        const int lc = 128 * bj + lc0;
                        if (kind == 0) {
                            const int col = 256 * (pn - 8) + lc;
                            u32x4 w; w.x = pk2(o[0], o[1]); w.y = pk2(o[2], o[3]); w.z = pk2(o[4], o[5]); w.w = pk2(o[6], o[7]);
                            *(u32x4*)(VD + (size_t)keyrow(row) * 512 + col) = w;
                            if (!sample) { float* op = out + OUT_DV + ((size_t)(pm * 2 + layer) * 256 + (row & 255)) * 512 + col;
                                *(f32x4*)op = (f32x4){o[0], o[1], o[2], o[3]}; *(f32x4*)(op + 4) = (f32x4){o[4], o[5], o[6], o[7]}; }
                        } else if (kind == 1 || (kind == 2 && bj == 0)) {
                            const int col = (kind == 1 ? 0 : 256) + lc;
                            u32x4 w; w.x = pk2(o[0], o[1]); w.y = pk2(o[2], o[3]); w.z = pk2(o[4], o[5]); w.w = pk2(o[6], o[7]);
                            *(u32x4*)(CQ + (size_t)row * 384 + col) = w; ssw += ssl;
                        } else if (kind == 2) {
                            float st = ssl; st += __shfl_xor(st, 16); st += __shfl_xor(st, 32);
                            if (live) {
                                float* kp = kperaw + (size_t)row * 32 + 8 * fq;
                                *(f32x4*)kp = (f32x4){o[0], o[1], o[2], o[3]}; *(f32x4*)(kp + 4) = (f32x4){o[4], o[5], o[6], o[7]};
                                if (fq == 0) kpess[row] = st;
                                if (!sample) { float* op = out + OUT_KPE + ((size_t)(pm * 2 + layer) * 256 + (row & 255)) * 32 + 8 * fq;
                                    *(f32x4*)op = (f32x4){o[0], o[1], o[2], o[3]}; *(f32x4*)(op + 4) = (f32x4){o[4], o[5], o[6], o[7]}; }
                            }
                        } else if (kind == 3) {
                            u32x4 w; w.x = pk2(o[0], o[1]); w.y = pk2(o[2], o[3]); w.z = pk2(o[4], o[5]); w.w = pk2(o[6], o[7]);
                            *(u32x4*)(CKVA + (size_t)row * 256 + lc) = w; ssw += ssl;
                            if (!sample) { float* op = out + OUT_CKV + ((size_t)(pm * 2 + layer) * 256 + (row & 255)) * 256 + lc;
                                *(f32x4*)op = (f32x4){o[0], o[1], o[2], o[3]}; *(f32x4*)(op + 4) = (f32x4){o[4], o[5], o[6], o[7]}; }
                        } else {
                            const int col = 256 * (pn - 13) + lc;
                            u32x4 w; w.x = pk2(sigmoidf_(o[0]), sigmoidf_(o[1])); w.y = pk2(sigmoidf_(o[2]), sigmoidf_(o[3])); w.z = pk2(sigmoidf_(o[4]), sigmoidf_(o[5])); w.w = pk2(sigmoidf_(o[6]), sigmoidf_(o[7]));
                            *(u32x4*)(G + (size_t)row * 3072 + col) = w;
                        }
                    }
                    if (kind == 1 || kind == 2 || kind == 3) {
                        ssw += __shfl_xor(ssw, 16); ssw += __shfl_xor(ssw, 32);
                        if (fq == 0) { if (kind == 1) cqpart[(size_t)row * 8 + wc] = ssw; else if (kind == 2) cqpart[(size_t)row * 8 + 4 + wc] = ssw; else ckvpart[(size_t)row * 4 + wc] = ssw; }
                    }
                }
        }
    }
};

struct EpiQM {
    static constexpr bool HOOK = false, SPLIT = false;
    unsigned char* ws0; const float* gqm;
    __device__ __forceinline__ void hook(Acc&, const Unit&, int, int, int, int, int) const {}
    __device__ __forceinline__ void operator()(const Acc& acc, const Unit& u, int wr, int wc, int fr, int fq) const {
        unsigned char* ws = launder(ws0);
        const float* cosM = (const float*)(ws + WS_TAB) + 2048; const float* sinM = cosM + 512; bf16_t* QM = (bf16_t*)(ws + WS_QM); float* qss = (float*)(ws + WS_QSS);
        const int pm = u.pm, pn = u.pn; const bool sample = pm >= 16; const int rbase = pm * 256 + wr * 64 + fr;
#pragma unroll
        for (int bj = 0; bj < 2; ++bj) {
            const int blk = 8 * pn + 4 * bj + wc, h = blk / 3, part = blk - 3 * h;
            int d0, d1;
            if (part < 2) { d0 = 32 * part + 4 * fq; d1 = d0 + 16; } else { d0 = 64 + 16 * (fq >> 1) + 4 * (fq & 1); d1 = d0 + 8; }
            const f32x4 g0 = *(const f32x4*)(gqm + d0), g1 = *(const f32x4*)(gqm + d1);
#pragma unroll
            for (int ai = 0; ai < 2; ++ai)
#pragma unroll
                for (int m = 0; m < 4; ++m) {
                    const int row = rbase + ai * 128 + m * 16;
                    const f32x4 z0 = acc[ai][bj][m][0], z1 = acc[ai][bj][m][1];
                    float ss = sum4(z0 * z0) + sum4(z1 * z1); ss += __shfl_xor(ss, 16); ss += __shfl_xor(ss, 32);
                    if (fq == 0) qss[(size_t)row * 24 + blk] = ss;
                    f32x4 y0 = z0 * g0, y1 = z1 * g1;
                    if (part == 2 && sample) {
                        const int s = row & 2047, pos = (fq >> 1) == 0 ? (s >> 6) : (s & 63);
                        const f32x4 c4 = *(const f32x4*)(cosM + pos * 8 + 4 * (fq & 1)), s4 = *(const f32x4*)(sinM + pos * 8 + 4 * (fq & 1));
                        const f32x4 x1 = y0, x2 = y1; y0 = x1 * c4 - x2 * s4; y1 = x2 * c4 + x1 * s4;
                    }
                    bf16_t* dp = QM + (size_t)row * 768 + 96 * h;
                    u32x2 w0, w1; w0.x = pk2(y0[0], y0[1]); w0.y = pk2(y0[2], y0[3]); w1.x = pk2(y1[0], y1[1]); w1.y = pk2(y1[2], y1[3]);
                    *(u32x2*)(dp + d0) = w0; *(u32x2*)(dp + d1) = w1;
                    MEMFENCE();
                }
        }
    }
};

struct EpiKV {
    static constexpr bool HOOK = false, SPLIT = false;
    unsigned char* ws0; float* out0; const float* gkm; const float* gkva; int layer;
    __device__ __forceinline__ void hook(Acc&, const Unit&, int, int, int, int, int) const {}
    __device__ __forceinline__ void operator()(const Acc& acc, const Unit& u, int wr, int wc, int fr, int fq) const {
        unsigned char* ws = launder(ws0); float* out = launder(out0);
        const float* ckvpart = (const float*)(ws + WS_CKVP); const float* kpess = (const float*)(ws + WS_KPESS); const float* kperaw = (const float*)(ws + WS_KPER);
        const float* cosM = (const float*)(ws + WS_TAB) + 2048; const float* sinM = cosM + 512; bf16_t* KM = (bf16_t*)(ws + WS_KM); bf16_t* VM = (bf16_t*)(ws + WS_VM);
        const int pm = u.pm, pn = u.pn; const int rbase = pm * 256 + wr * 64 + fr;
        const bool newtok = pm < 32, rope = pm >= 16 && pm < 32;
#pragma unroll
        for (int ai = 0; ai < 2; ++ai)
#pragma unroll
            for (int m = 0; m < 4; ++m) {
                const int row = rbase + ai * 128 + m * 16; const int kr = keyrow(row);
                float rc = 1.0f;
                if (newtok) { const f32x4 p = *(const f32x4*)(ckvpart + (size_t)row * 4); rc = rsqrtf(sum4(p) * (1.0f / 256.0f) + EPSF); }
                if (pn < 2) {
                    const int h = 4 * pn + wc;
                    f32x4 v[2][2]; float ss = 0.f;
#pragma unroll
                    for (int bj = 0; bj < 2; ++bj)
#pragma unroll
                        for (int n = 0; n < 2; ++n) { v[bj][n] = acc[ai][bj][m][n] * rc; ss += sum4(v[bj][n] * v[bj][n]); }
                    ss += __shfl_xor(ss, 16); ss += __shfl_xor(ss, 32);
                    ss += kpess[row];
                    const float rk = rsqrtf(ss * (1.0f / 96.0f) + EPSF);
                    bf16_t* dp = KM + (size_t)kr * 768 + 96 * h;
#pragma unroll
                    for (int bj = 0; bj < 2; ++bj)
#pragma unroll
                        for (int n = 0; n < 2; ++n) { const int d = 32 * bj + 16 * n + 4 * fq; const f32x4 x = v[bj][n] * rk * *(const f32x4*)(gkm + d);
                            u32x2 w; w.x = pk2(x[0], x[1]); w.y = pk2(x[2], x[3]); *(u32x2*)(dp + d) = w; }
                    const int e0 = 16 * (fq >> 1) + 4 * (fq & 1);
                    f32x4 x1 = *(const f32x4*)(kperaw + (size_t)row * 32 + e0) * rk * *(const f32x4*)(gkm + 64 + e0);
                    f32x4 x2 = *(const f32x4*)(kperaw + (size_t)row * 32 + e0 + 8) * rk * *(const f32x4*)(gkm + 64 + e0 + 8);
                    if (rope) {
                        const int s = row & 2047, pos = (fq >> 1) == 0 ? (s >> 6) : (s & 63);
                        const f32x4 c4 = *(const f32x4*)(cosM + pos * 8 + 4 * (fq & 1)), s4 = *(const f32x4*)(sinM + pos * 8 + 4 * (fq & 1));
                        const f32x4 a = x1, b = x2; x1 = a * c4 - b * s4; x2 = b * c4 + a * s4;
                    }
                    u32x2 w0, w1; w0.x = pk2(x1[0], x1[1]); w0.y = pk2(x1[2], x1[3]); w1.x = pk2(x2[0], x2[1]); w1.y = pk2(x2[2], x2[3]);
                    *(u32x2*)(dp + 64 + e0) = w0; *(u32x2*)(dp + 64 + e0 + 8) = w1;
                } else {
#pragma unroll
                    for (int bj = 0; bj < 2; ++bj) {
                        const int lc = 256 * (pn - 2) + 128 * bj + 32 * wc + 8 * fq;
                        const f32x4 a = acc[ai][bj][m][0] * rc, b = acc[ai][bj][m][1] * rc;
                        u32x4 w; w.x = pk2(a[0], a[1]); w.y = pk2(a[2], a[3]); w.z = pk2(b[0], b[1]); w.w = pk2(b[2], b[3]);
                        *(u32x4*)(VM + (size_t)kr * 512 + lc) = w;
                    }
                    if (pn == 2 && pm < 16) {
                        float* op = out + OUT_CKV + ((size_t)(pm * 2 + layer) * 256 + (row & 255)) * 256 + 64 * wc + 4 * fq;
#pragma unroll
                        for (int t = 0; t < 4; ++t) { f32x4 x = *(f32x4*)(op + 16 * t); x = x * rc * *(const f32x4*)(gkva + 64 * wc + 4 * fq + 16 * t); *(f32x4*)(op + 16 * t) = x; }
                    }
                }
                MEMFENCE();
            }
    }
};

struct EpiMerge {
    static constexpr bool HOOK = true, SPLIT = true;
    unsigned char* ws0; int cnt_off;
    __device__ __forceinline__ void hook(Acc& acc, const Unit& u, int t, int wr, int wc, int fr, int fq) const {
        unsigned char* ws = launder(ws0); const bf16_t* G = (const bf16_t*)(ws + WS_R1);
        const int seg = (t == 8) ? 0 : 1; int rbase = u.pm * 256 + wr * 64 + fr; asm volatile("" : "+v"(rbase));
#pragma unroll
        for (int ai = 0; ai < 2; ++ai) {
            u32x4 ga[4][2], gb[4][2];
#pragma unroll
            for (int m = 0; m < 4; ++m)
#pragma unroll
                for (int bj = 0; bj < 2; ++bj) { const bf16_t* gp = G + (size_t)(rbase + ai * 128 + m * 16) * 3072 + seg * 1024 + 256 * u.pn + 128 * bj + 32 * wc + 8 * fq;
                    ga[m][bj] = *(const u32x4*)gp; gb[m][bj] = *(const u32x4*)(gp + 1024); }
#pragma unroll
            for (int m = 0; m < 4; ++m)
#pragma unroll
                for (int bj = 0; bj < 2; ++bj) { const u32x4 a4 = ga[m][bj], b4 = gb[m][bj];
                    acc[ai][bj][m][0][0] *= bflo(a4.x) * __builtin_amdgcn_rcpf(bflo(b4.x)); acc[ai][bj][m][0][1] *= bfhi(a4.x) * __builtin_amdgcn_rcpf(bfhi(b4.x));
                    acc[ai][bj][m][0][2] *= bflo(a4.y) * __builtin_amdgcn_rcpf(bflo(b4.y)); acc[ai][bj][m][0][3] *= bfhi(a4.y) * __builtin_amdgcn_rcpf(bfhi(b4.y));
                    acc[ai][bj][m][1][0] *= bflo(a4.z) * __builtin_amdgcn_rcpf(bflo(b4.z)); acc[ai][bj][m][1][1] *= bfhi(a4.z) * __builtin_amdgcn_rcpf(bfhi(b4.z));
                    acc[ai][bj][m][1][2] *= bflo(a4.w) * __builtin_amdgcn_rcpf(bflo(b4.w)); acc[ai][bj][m][1][3] *= bfhi(a4.w) * __builtin_amdgcn_rcpf(bfhi(b4.w)); }
            MEMFENCE();
        }
    }
    __device__ __forceinline__ void pre(Acc& acc, const Unit& u, int nsplit, int wr, int wc, int fr, int fq) const {
        unsigned char* ws = launder(ws0); const bf16_t* G = (const bf16_t*)(ws + WS_R1);
        const int gsel = (nsplit == 2 && u.ks == 0) ? 1 : 2; const int rbase = u.pm * 256 + wr * 64 + fr;
#pragma unroll
        for (int ai = 0; ai < 2; ++ai) {
            u32x4 gg[4][2];
#pragma unroll
            for (int m = 0; m < 4; ++m)
#pragma unroll
                for (int bj = 0; bj < 2; ++bj) gg[m][bj] = *(const u32x4*)(G + (size_t)(rbase + ai * 128 + m * 16) * 3072 + gsel * 1024 + 256 * u.pn + 128 * bj + 32 * wc + 8 * fq);
#pragma unroll
            for (int m = 0; m < 4; ++m)
#pragma unroll
                for (int bj = 0; bj < 2; ++bj) { const u32x4 g = gg[m][bj];
                    acc[ai][bj][m][0][0] *= bflo(g.x); acc[ai][bj][m][0][1] *= bfhi(g.x); acc[ai][bj][m][0][2] *= bflo(g.y); acc[ai][bj][m][0][3] *= bfhi(g.y);
                    acc[ai][bj][m][1][0] *= bflo(g.z); acc[ai][bj][m][1][1] *= bfhi(g.z); acc[ai][bj][m][1][2] *= bflo(g.w); acc[ai][bj][m][1][3] *= bfhi(g.w); }
            MEMFENCE();
        }
    }
    __device__ __forceinline__ bool exchange(Acc& acc, int tile, int ks, int wid, int lane) const { unsigned char* ws = launder(ws0); return splitk_exchange(acc, ws, cnt_off, tile, ks, wid, lane); }
    __device__ __forceinline__ void operator()(const Acc& acc, const Unit& u, int wr, int wc, int fr, int fq) const {
        unsigned char* ws = launder(ws0); bf16_t* MG = (bf16_t*)(ws + WS_MG);
        const int rbase = u.pm * 256 + wr * 64 + fr;
#pragma unroll
        for (int ai = 0; ai < 2; ++ai)
#pragma unroll
            for (int m = 0; m < 4; ++m) {
                const int row = rbase + ai * 128 + m * 16;
#pragma unroll
                for (int bj = 0; bj < 2; ++bj) {
                    const int col = 256 * u.pn + 128 * bj + 32 * wc + 8 * fq;
                    const f32x4 a = acc[ai][bj][m][0], b = acc[ai][bj][m][1];
                    u32x4 w; w.x = pk2(a[0], a[1]); w.y = pk2(a[2], a[3]); w.z = pk2(b[0], b[1]); w.w = pk2(b[2], b[3]);
                    *(u32x4*)(MG + (size_t)row * 1024 + col) = w;
                }
            }
    }
};

struct EpiRes {
    static constexpr bool HOOK = false, SPLIT = true;
    const float* base_p; const float* base_s;
    float* out0;
    unsigned char* ws0; int gate_off;
    const float* cs_g; int cs_off;
    int cnt_off;
    __device__ __forceinline__ void hook(Acc&, const Unit&, int, int, int, int, int) const {}
    __device__ __forceinline__ void pre(Acc&, const Unit&, int, int, int, int, int) const {}
    __device__ __forceinline__ bool exchange(Acc& acc, int tile, int ks, int wid, int lane) const { unsigned char* ws = launder(ws0); return splitk_exchange(acc, ws, cnt_off, tile, ks, wid, lane); }
    __device__ __forceinline__ void operator()(const Acc& acc, const Unit& u, int wr, int wc, int fr, int fq) const {
        unsigned char* ws = launder(ws0); float* out = launder(out0);
        const float* gate = (const float*)(ws + WS_MOD) + gate_off; const float* cs_sc = (const float*)(ws + WS_MOD) + cs_off; bf16_t* XN = (bf16_t*)(ws + WS_XN); float* xss = (float*)(ws + WS_XSS);
        const int pm = u.pm, pn = u.pn; const int cond = pm < 16 ? 0 : 1 + ((pm - 16) >> 3);
        const int rbase = pm * 256 + wr * 64 + fr;
        const bool nxt = cs_g != nullptr;
        f32x4 gt[2][2], cs[2][2];
#pragma unroll
        for (int bj = 0; bj < 2; ++bj)
#pragma unroll
            for (int n = 0; n < 2; ++n) { const int col = 256 * pn + 128 * bj + 32 * wc + 8 * fq + 4 * n; gt[bj][n] = *(const f32x4*)(gate + cond * 6144 + col);
                if (nxt) cs[bj][n] = *(const f32x4*)(cs_g + col) * (*(const f32x4*)(cs_sc + cond * 6144 + col) + 1.0f); else cs[bj][n] = (f32x4){0.f, 0.f, 0.f, 0.f}; }
#pragma unroll
        for (int aim = 0; aim < 4; ++aim) { const int ai = aim >> 1, m0 = (aim & 1) * 2;
            f32x4 bv[4][2][2];
#pragma unroll
            for (int m = m0; m < m0 + 2; ++m) { const int row = rbase + ai * 128 + m * 16; const float* bp = (row < 4096 ? base_p + (size_t)row * 1024 : base_s + (size_t)(row - 4096) * 1024);
#pragma unroll
                for (int bj = 0; bj < 2; ++bj) { const int col = 256 * pn + 128 * bj + 32 * wc + 8 * fq; bv[m][bj][0] = *(const f32x4*)(bp + col); bv[m][bj][1] = *(const f32x4*)(bp + col + 4); } }
#pragma unroll
            for (int m = m0; m < m0 + 2; ++m) {
                const int row = rbase + ai * 128 + m * 16;
                float ss = 0.f;
#pragma unroll
                for (int bj = 0; bj < 2; ++bj) {
                    const int col = 256 * pn + 128 * bj + 32 * wc + 8 * fq;
                    const f32x4 x0 = bv[m][bj][0] + gt[bj][0] * acc[ai][bj][m][0], x1 = bv[m][bj][1] + gt[bj][1] * acc[ai][bj][m][1];
                    *(f32x4*)(out + (size_t)row * 1024 + col) = x0; *(f32x4*)(out + (size_t)row * 1024 + col + 4) = x1;
                    if (nxt) {
                        ss += sum4(x0 * x0) + sum4(x1 * x1);
                        const f32x4 a = x0 * cs[bj][0], b = x1 * cs[bj][1];
                        u32x4 w; w.x = pk2(a[0], a[1]); w.y = pk2(a[2], a[3]); w.z = pk2(b[0], b[1]); w.w = pk2(b[2], b[3]);
                        *(u32x4*)(XN + (size_t)row * 1024 + col) = w;
                    }
                }
                if (nxt) { ss += __shfl_xor(ss, 16); ss += __shfl_xor(ss, 32); if (fq == 0) xss[(size_t)row * 16 + 4 * pn + wc] = ss; }
            }
            MEMFENCE();
        }
    }
};

struct EpiUp {
    static constexpr bool HOOK = false, SPLIT = false;
    unsigned char* ws0; int layer;
    __device__ __forceinline__ void hook(Acc&, const Unit&, int, int, int, int, int) const {}
    __device__ __forceinline__ void operator()(const Acc& acc, const Unit& u, int wr, int wc, int fr, int fq) const {
        unsigned char* ws = launder(ws0);
        const float* xss = (const float*)(ws + WS_XSS); const float* bias = (const float*)(ws + WS_BIAS2) + (size_t)layer * 3 * 4096; bf16_t* H = (bf16_t*)(ws + WS_R1);
        const int pm = u.pm, pn = u.pn; const int cond = pm < 16 ? 0 : 1 + ((pm - 16) >> 3);
        const int rbase = pm * 256 + wr * 64 + fr;
        f32x4 bv[2][2];
#pragma unroll
        for (int bj = 0; bj < 2; ++bj)
#pragma unroll
            for (int n = 0; n < 2; ++n) bv[bj][n] = *(const f32x4*)(bias + cond * 4096 + 256 * pn + 128 * bj + 32 * wc + 8 * fq + 4 * n);
        float ri8[8]; rinv8(xss, rbase, fq, ri8);
#pragma unroll
        for (int ai = 0; ai < 2; ++ai)
#pragma unroll
            for (int m = 0; m < 4; ++m) {
                const int row = rbase + ai * 128 + m * 16; const float ri = ri8[ai * 4 + m];
#pragma unroll
                for (int bj = 0; bj < 2; ++bj) {
                    const int col = 256 * pn + 128 * bj + 32 * wc + 8 * fq;
                    f32x4 a = acc[ai][bj][m][0] * ri + bv[bj][0], b = acc[ai][bj][m][1] * ri + bv[bj][1];
#pragma unroll
                    for (int i = 0; i < 4; ++i) { a[i] = fmaxf(a[i], 0.f); a[i] *= a[i]; b[i] = fmaxf(b[i], 0.f); b[i] *= b[i]; }
                    u32x4 w; w.x = pk2(a[0], a[1]); w.y = pk2(a[2], a[3]); w.z = pk2(b[0], b[1]); w.w = pk2(b[2], b[3]);
                    *(u32x4*)(H + (size_t)row * 4096 + col) = w;
                }
            }
    }
};

__device__ __forceinline__ s16x4 vtr(const LAS unsigned char* p) { return __builtin_bit_cast(s16x4, __builtin_amdgcn_ds_read_tr16_b64_v4i16((LAS v4i16_t*)p)); }
__device__ __forceinline__ bf16x8 packp(const f32x16& p, int b) {
    u32x4 w; w.x = pk2(p[8 * b + 0], p[8 * b + 1]); w.y = pk2(p[8 * b + 2], p[8 * b + 3]); w.z = pk2(p[8 * b + 4], p[8 * b + 5]); w.w = pk2(p[8 * b + 6], p[8 * b + 7]);
    return __builtin_bit_cast(bf16x8, w);
}
#define MFMA32(a, b, c) __builtin_amdgcn_mfma_f32_32x32x16_bf16((a), (b), (c), 0, 0, 0)

constexpr int DK_LP = 272, DV_LP = 320, DK_BUF = 64 * DK_LP, DV_BUF = 64 * DV_LP;
__device__ __forceinline__ void diff_unit(LAS unsigned char* lds, const bf16_t* QD, const bf16_t* KD, const bf16_t* VD, bf16_t* ACAT, int qrow0, int kr0, int NT, int h,
                                          float lam, float outscale, const float* subln, int tstart, int wave0) {
    const int tid = mk_tid(wave0);
    const int lane = tid & 63, w = __builtin_amdgcn_readfirstlane(tid >> 6), r32 = lane & 31, hi = lane >> 5, c = w >> 2, wq = w & 3;
    bf16x8 qf[4];
    { const bf16_t* qp = QD + (size_t)(qrow0 + 32 * wq + r32) * 512 + h * 128 + c * 64 + hi * 8;
#pragma unroll
      for (int s = 0; s < 4; ++s) qf[s] = __builtin_bit_cast(bf16x8, gld16(qp + 16 * s)); }
    const int srow0 = tid >> 4, sch = tid & 15;
    const bf16_t* ksrc = KD + (size_t)(kr0 + srow0) * 512 + h * 128 + sch * 8;
    const bf16_t* vsrc = VD + (size_t)(kr0 + srow0) * 512 + h * 128 + sch * 8;
    const int kdst = srow0 * DK_LP + sch * 16, vdst = 2 * DK_BUF + srow0 * DV_LP + sch * 16;
#define TROT(t) (((t) + tstart) % NT)
#define LBAR() asm volatile("s_waitcnt lgkmcnt(0)\n\ts_barrier" ::: "memory")
#define D_LOAD(K_, V_, t) do { const int tt_ = TROT(t); _Pragma("unroll") for (int p_ = 0; p_ < 2; ++p_) { K_[p_] = gld16(ksrc + (size_t)(tt_ * 64 + 32 * p_) * 512); V_[p_] = gld16(vsrc + (size_t)(tt_ * 64 + 32 * p_) * 512); } } while (0)
#define D_WRITE(K_, V_, b) do { _Pragma("unroll") for (int p_ = 0; p_ < 2; ++p_) { *(LAS u32x4*)(lds + (b) * DK_BUF + kdst + p_ * 32 * DK_LP) = K_[p_]; *(LAS u32x4*)(lds + (b) * DV_BUF + vdst + p_ * 32 * DV_LP) = V_[p_]; } } while (0)
    const int kfoff = r32 * DK_LP + c * 128 + hi * 16;
    const int g4 = lane >> 4, i16 = lane & 15;
    const int vfoff = 2 * DK_BUF + (4 * (g4 >> 1) + (i16 >> 2)) * DV_LP + (16 * (g4 & 1) + 4 * (i16 & 3)) * 2;
    u32x4 kA[2], vA[2], kB[2], vB[2];
    D_LOAD(kA, vA, 0); D_LOAD(kB, vB, 1);
    D_WRITE(kA, vA, 0);
    LBAR();
    f32x16 o[4];
#pragma unroll
    for (int d = 0; d < 4; ++d)
#pragma unroll
        for (int r = 0; r < 16; ++r) o[d][r] = 0.f;
    float lsum = 0.f;
#define SGB(mask, n) __builtin_amdgcn_sched_group_barrier((mask), (n), 0)
#define D_VLOAD(S_, ks) do { _Pragma("unroll") for (int dt = 0; dt < 4; ++dt) { S_[2 * dt] = vtr(vb + (ks) * 16 * DV_LP + dt * 64); S_[2 * dt + 1] = vtr(vb + (ks) * 16 * DV_LP + 8 * DV_LP + dt * 64); } } while (0)
#define D_PV(S_, ks) do { const bf16x8 pa = ((ks) < 2) ? packp(p0, (ks) & 1) : packp(p1, (ks) & 1); \
        _Pragma("unroll") for (int dt = 0; dt < 4; ++dt) { const s16x4 lo = S_[2 * dt], hh = S_[2 * dt + 1]; \
            const bf16x8 vf = (bf16x8){lo[0], lo[1], lo[2], lo[3], hh[0], hh[1], hh[2], hh[3]}; o[dt] = MFMA32(pa, vf, o[dt]); } } while (0)
#define D_ITER(t, KL, VL, KW, VW) do { \
        const int b = (t) & 1; \
        if ((t) + 2 < NT) D_LOAD(KL, VL, (t) + 2); \
        f32x16 p0, p1; \
        _Pragma("unroll") for (int r = 0; r < 16; ++r) { p0[r] = 0.f; p1[r] = 0.f; } \
        const LAS unsigned char* kb = lds + b * DK_BUF + kfoff; \
        const LAS unsigned char* vb = lds + b * DV_BUF + vfoff; \
        bf16x8 kf[8]; s16x4 va[8], vc[8]; \
        _Pragma("unroll") for (int s = 0; s < 4; ++s) { kf[2 * s] = *(const LAS bf16x8*)(kb + s * 32); kf[2 * s + 1] = *(const LAS bf16x8*)(kb + 32 * DK_LP + s * 32); } \
        D_VLOAD(va, 0); \
        _Pragma("unroll") for (int s = 0; s < 4; ++s) { p0 = MFMA32(kf[2 * s], qf[s], p0); p1 = MFMA32(kf[2 * s + 1], qf[s], p1); } \
        SGB(0x100, 16); SGB(0x008, 8); \
        float ls = 0.f; \
        _Pragma("unroll") for (int r = 0; r < 16; ++r) { p0[r] = __builtin_amdgcn_exp2f(p0[r]); p1[r] = __builtin_amdgcn_exp2f(p1[r]); ls += p0[r] + p1[r]; } \
        lsum += ls; \
        D_VLOAD(vc, 1); D_PV(va, 0); SGB(0x100, 8); SGB(0x008, 4); \
        D_VLOAD(va, 2); D_PV(vc, 1); SGB(0x100, 8); SGB(0x008, 4); \
        D_VLOAD(vc, 3); D_PV(va, 2); SGB(0x100, 8); SGB(0x008, 4); \
        D_PV(vc, 3); \
        if ((t) + 1 < NT) D_WRITE(KW, VW, b ^ 1); \
        LBAR(); \
    } while (0)
    for (int t = 0; t < NT; t += 2) {
        D_ITER(t, kA, vA, kB, vB);
        D_ITER(t + 1, kB, vB, kA, vA);
    }
#undef D_ITER
#undef D_VLOAD
#undef D_PV
#undef D_LOAD
#undef D_WRITE
#undef TROT
    lsum += __shfl_xor(lsum, 32);
    const float linv = 1.0f / lsum;
#pragma unroll
    for (int r = 0; r < 16; ++r) { const float l_ = __shfl(linv, crow(r, hi));
#pragma unroll
        for (int dt = 0; dt < 4; ++dt) o[dt][r] *= l_; }
    LAS float* xch = (LAS float*)lds;
    if (c == 1) {
#pragma unroll
        for (int dt = 0; dt < 4; ++dt)
#pragma unroll
            for (int r = 0; r < 16; ++r) xch[((wq * 4 + dt) * 16 + r) * 64 + lane] = o[dt][r];
    }
    __syncthreads();
    if (c == 0) {
        float ss[16];
#pragma unroll
        for (int r = 0; r < 16; ++r) ss[r] = 0.f;
#pragma unroll
        for (int dt = 0; dt < 4; ++dt)
#pragma unroll
            for (int r = 0; r < 16; ++r) { const float v = o[dt][r] - lam * xch[((wq * 4 + dt) * 16 + r) * 64 + lane]; o[dt][r] = v; ss[r] += v * v; }
#pragma unroll
        for (int r = 0; r < 16; ++r) {
            float s = ss[r];
            s += __shfl_xor(s, 1); s += __shfl_xor(s, 2); s += __shfl_xor(s, 4); s += __shfl_xor(s, 8); s += __shfl_xor(s, 16);
            ss[r] = rsqrtf(s * (1.0f / 128.0f) + EPSF) * outscale;
        }
#pragma unroll
        for (int dt = 0; dt < 4; ++dt) {
            const float gsl = subln[32 * dt + r32];
#pragma unroll
            for (int r = 0; r < 16; ++r) {
                const float v = o[dt][r] * ss[r] * gsl;
                ACAT[(size_t)(qrow0 + 32 * wq + crow(r, hi)) * 1536 + 512 + h * 128 + 32 * dt + r32] = (bf16_t)(pk2(v, 0.f) & 0xffffu);
            }
        }
    }
    __syncthreads();
}

constexpr int MK_LP = 208, MV_LP = 192, MK_BUF = 64 * MK_LP, MV_BUF = 64 * MV_LP;
__device__ __forceinline__ void mla_unit(LAS unsigned char* lds, const bf16_t* QM, const float* qss, const float* cqpart, const bf16_t* KM, const bf16_t* VM, bf16_t* ACAT,
                                         int qrow0, int kr0, int NT, int h, int tstart, int wave0) {
    const int tid = mk_tid(wave0);
    const int lane = tid & 63, w = __builtin_amdgcn_readfirstlane(tid >> 6), r32 = lane & 31, hi = lane >> 5;
    bf16x8 qf[6];
    {
        const int row = qrow0 + 32 * w + r32;
        const f32x4 c0 = *(const f32x4*)(cqpart + (size_t)row * 8), c1 = *(const f32x4*)(cqpart + (size_t)row * 8 + 4);
        const float r1 = rsqrtf((sum4(c0) + sum4(c1)) * (1.0f / 384.0f) + EPSF);
        const float qs = qss[(size_t)row * 24 + 3 * h] + qss[(size_t)row * 24 + 3 * h + 1] + qss[(size_t)row * 24 + 3 * h + 2];
        const float sq = r1 * rsqrtf(r1 * r1 * qs * (1.0f / 96.0f) + EPSF);
        const float fq_ = sq * 0.10206207261596575f * LOG2E;
        const bf16_t* qp = QM + (size_t)row * 768 + 96 * h + hi * 8;
#pragma unroll
        for (int s = 0; s < 6; ++s) {
            const u32x4 q = gld16(qp + 16 * s);
            u32x4 z; z.x = pk2(bflo(q.x) * fq_, bfhi(q.x) * fq_); z.y = pk2(bflo(q.y) * fq_, bfhi(q.y) * fq_); z.z = pk2(bflo(q.z) * fq_, bfhi(q.z) * fq_); z.w = pk2(bflo(q.w) * fq_, bfhi(q.w) * fq_);
            qf[s] = __builtin_bit_cast(bf16x8, z);
        }
    }
    const int kr_a = tid / 12, kc_a = tid - 12 * kr_a; const int cb = 512 + tid; const int kr_b = cb / 12, kc_b = cb - 12 * kr_b; const bool has_b = tid < 256;
    const bf16_t* ksrc_a = KM + (size_t)(kr0 + kr_a) * 768 + 96 * h + kc_a * 8;
    const bf16_t* ksrc_b = KM + (size_t)(kr0 + kr_b) * 768 + 96 * h + kc_b * 8;
    const bf16_t* vsrc = VM + (size_t)(kr0 + (tid >> 3)) * 512 + 64 * h + (tid & 7) * 8;
    const int kdst_a = kr_a * MK_LP + kc_a * 16, kdst_b = kr_b * MK_LP + kc_b * 16, vdst = 2 * MK_BUF + (tid >> 3) * MV_LP + (tid & 7) * 16;
#define TROT(t) (((t) + tstart) % NT)
#define M_LOAD(KA_, KB_, V_, t) do { const int tt_ = TROT(t); KA_ = gld16(ksrc_a + (size_t)tt_ * 64 * 768); if (has_b) KB_ = gld16(ksrc_b + (size_t)tt_ * 64 * 768); V_ = gld16(vsrc + (size_t)tt_ * 64 * 512); } while (0)
#define M_WRITE(KA_, KB_, V_, b) do { *(LAS u32x4*)(lds + (b) * MK_BUF + kdst_a) = KA_; if (has_b) *(LAS u32x4*)(lds + (b) * MK_BUF + kdst_b) = KB_; *(LAS u32x4*)(lds + (b) * MV_BUF + vdst) = V_; } while (0)
    const int kfoff = r32 * MK_LP + hi * 16;
    const int g4 = lane >> 4, i16 = lane & 15;
    const int vfoff = 2 * MK_BUF + (4 * (g4 >> 1) + (i16 >> 2)) * MV_LP + (16 * (g4 & 1) + 4 * (i16 & 3)) * 2;
    u32x4 kaA, kbA, vA, kaB, kbB, vB;
    kbA = (u32x4){0u, 0u, 0u, 0u}; kbB = kbA;
    M_LOAD(kaA, kbA, vA, 0); M_LOAD(kaB, kbB, vB, 1);
    M_WRITE(kaA, kbA, vA, 0);
    LBAR();
    f32x16 o[2];
#pragma unroll
    for (int d = 0; d < 2; ++d)
#pragma unroll
        for (int r = 0; r < 16; ++r) o[d][r] = 0.f;
    float lsum = 0.f;
#define M_VLOAD(S_, ks) do { _Pragma("unroll") for (int dt = 0; dt < 2; ++dt) { S_[2 * dt] = vtr(vb + (ks) * 16 * MV_LP + dt * 64); S_[2 * dt + 1] = vtr(vb + (ks) * 16 * MV_LP + 8 * MV_LP + dt * 64); } } while (0)
#define M_PV(S_, ks) do { const bf16x8 pa = ((ks) < 2) ? packp(p0, (ks) & 1) : packp(p1, (ks) & 1); \
        _Pragma("unroll") for (int dt = 0; dt < 2; ++dt) { const s16x4 lo = S_[2 * dt], hh = S_[2 * dt + 1]; \
            const bf16x8 vf = (bf16x8){lo[0], lo[1], lo[2], lo[3], hh[0], hh[1], hh[2], hh[3]}; o[dt] = MFMA32(pa, vf, o[dt]); } } while (0)
#define M_ITER(t, KAL, KBL, VL, KAW, KBW, VW) do { \
        const int b = (t) & 1; \
        if ((t) + 2 < NT) M_LOAD(KAL, KBL, VL, (t) + 2); \
        f32x16 p0, p1; \
        _Pragma("unroll") for (int r = 0; r < 16; ++r) { p0[r] = 0.f; p1[r] = 0.f; } \
        const LAS unsigned char* kb = lds + b * MK_BUF + kfoff; \
        const LAS unsigned char* vb = lds + b * MV_BUF + vfoff; \
        bf16x8 kf[12]; s16x4 va[4], vc[4]; \
        _Pragma("unroll") for (int s = 0; s < 6; ++s) { kf[2 * s] = *(const LAS bf16x8*)(kb + s * 32); kf[2 * s + 1] = *(const LAS bf16x8*)(kb + 32 * MK_LP + s * 32); } \
        M_VLOAD(va, 0); \
        _Pragma("unroll") for (int s = 0; s < 6; ++s) { p0 = MFMA32(kf[2 * s], qf[s], p0); p1 = MFMA32(kf[2 * s + 1], qf[s], p1); } \
        SGB(0x100, 16); SGB(0x008, 12); \
        float ls = 0.f; \
        _Pragma("unroll") for (int r = 0; r < 16; ++r) { p0[r] = __builtin_amdgcn_exp2f(p0[r]); p1[r] = __builtin_amdgcn_exp2f(p1[r]); ls += p0[r] + p1[r]; } \
        lsum += ls; \
        M_VLOAD(vc, 1); M_PV(va, 0); SGB(0x100, 4); SGB(0x008, 2); \
        M_VLOAD(va, 2); M_PV(vc, 1); SGB(0x100, 4); SGB(0x008, 2); \
        M_VLOAD(vc, 3); M_PV(va, 2); SGB(0x100, 4); SGB(0x008, 2); \
        M_PV(vc, 3); \
        if ((t) + 1 < NT) M_WRITE(KAW, KBW, VW, b ^ 1); \
        LBAR(); \
    } while (0)
    for (int t = 0; t < NT; t += 2) {
        M_ITER(t, kaA, kbA, vA, kaB, kbB, vB);
        M_ITER(t + 1, kaB, kbB, vB, kaA, kbA, vA);
    }
#undef M_ITER
#undef M_VLOAD
#undef M_PV
#undef SGB
#undef M_LOAD
#undef M_WRITE
#undef TROT
#undef LBAR
    lsum += __shfl_xor(lsum, 32);
    const float linv = 1.0f / lsum;
#pragma unroll
    for (int r = 0; r < 16; ++r) {
        const float l = __shfl(linv, crow(r, hi));
#pragma unroll
        for (int dt = 0; dt < 2; ++dt) {
            const float v = o[dt][r] * l;
            ACAT[(size_t)(qrow0 + 32 * w + crow(r, hi)) * 1536 + 1024 + 64 * h + 32 * dt + r32] = (bf16_t)(pk2(v, 0.f) & 0xffffu);
        }
    }
}

__device__ __forceinline__ void conv_item(LAS unsigned char* lds, const bf16_t* U, const float* dw, const float* cb, const float* gn, bf16_t* ACAT, int item, int wave0) {
    const int tid = mk_tid(wave0);
    const int lane = tid & 63, w = __builtin_amdgcn_readfirstlane(tid >> 6);
    const int cp = tid & 255, th = tid >> 8;
    const int t0 = item * 32;
    const int sstart = t0 < 4096 ? (t0 & ~255) : 4096 + ((t0 - 4096) & ~2047), send = sstart + (t0 < 4096 ? 256 : 2048);
    LAS float* red = (LAS float*)(lds + 126976);
    LAS float* rinvs = (LAS float*)(lds + 127488);
    {
        u32x4 v[8]; f32x4 wq[8];
#pragma unroll
        for (int k = 0; k < 8; ++k) {
            const int cidx = tid + 512 * k, r = cidx >> 6, ch = cidx & 63, row = t0 - 15 + r;
            v[k] = (u32x4){0u, 0u, 0u, 0u}; wq[k] = (f32x4){0.f, 0.f, 0.f, 0.f};
            if (cidx < 3968) { wq[k] = gldf4(dw + (size_t)cidx * 4); if (row >= sstart && row < send) v[k] = gld16(U + (size_t)row * 512 + ch * 8); }
        }
#pragma unroll
        for (int k = 0; k < 8; ++k) { const int cidx = tid + 512 * k; if (cidx < 3968) { *(LAS u32x4*)(lds + cidx * 16) = v[k]; *(LAS f32x4*)(lds + 63488 + cidx * 16) = wq[k]; } }
    }
    __syncthreads();
    float a0[16], a1[16];
#pragma unroll
    for (int i = 0; i < 16; ++i) { a0[i] = 0.f; a1[i] = 0.f; }
    const LAS unsigned char* ubase = lds + (16 * th) * 1024 + cp * 4;
    const LAS unsigned char* wbase = lds + 63488 + cp * 8;
#pragma unroll 1
    for (int j = 0; j < 31; ++j) {
        const f32x2_t wj = *(const LAS f32x2_t*)(wbase + j * 2048);
        const LAS unsigned char* up = ubase + j * 1024;
#pragma unroll
        for (int i = 0; i < 16; ++i) { const unsigned x = *(const LAS unsigned*)(up + i * 1024); a0[i] += wj.x * bflo(x); a1[i] += wj.y * bfhi(x); }
    }
    { const float b0 = cb[2 * cp], b1 = cb[2 * cp + 1];
#pragma unroll
      for (int i = 0; i < 16; ++i) { a0[i] += b0; a1[i] += b1; } }
#pragma unroll
    for (int i = 0; i < 16; ++i) { const float sq = wave_sum(a0[i] * a0[i] + a1[i] * a1[i]); if (lane == 0) red[(16 * th + i) * 4 + (w & 3)] = sq; }
    __syncthreads();
    if (tid < 32) { const f32x4 r4 = *(const LAS f32x4*)(red + tid * 4); rinvs[tid] = rsqrtf(sum4(r4) * (1.0f / 512.0f) + EPSF); }
    __syncthreads();
    const float g0 = gn[2 * cp], g1 = gn[2 * cp + 1];
#pragma unroll
    for (int i = 0; i < 16; ++i) {
        const float ri = rinvs[16 * th + i];
        const float v0 = a0[i] * ri * g0, v1 = a1[i] * ri * g1;
        *(unsigned*)(ACAT + (size_t)(t0 + 16 * th + i) * 1536 + 2 * cp) = pk2(v0 * sigmoidf_(v0), v1 * sigmoidf_(v1));
    }
    __syncthreads();
}

__device__ __forceinline__ int perm_off(int type, int rho) {
    const int n = rho >> 4, fq = (rho >> 2) & 3, i = rho & 3;
    return type == 0 ? rho : (type == 1 ? 8 * fq + 4 * n + i : 16 * (fq >> 1) + 8 * n + 4 * (fq & 1) + i);
}
struct TrItem { const float* W; const float* ksc; bf16_t* WT; int ldw, k0, n0, ldt, drow0, dk0, pt; float* bias; int bstride; int shoff; };
__device__ __forceinline__ void tr_load(const TrItem& it, f32x4 (&v)[8], int lane) {
    const int rsub = lane >> 3, c4 = lane & 7;
#pragma unroll
    for (int i = 0; i < 8; ++i) { v[i] = (f32x4){0.f, 0.f, 0.f, 0.f}; if (it.n0 >= 0) v[i] = gldf4(it.W + (size_t)(it.k0 + 8 * i + rsub) * it.ldw + it.n0 + 4 * c4); }
}
__device__ __forceinline__ void tr_process(const TrItem& it, const f32x4 (&v)[8], LAS float* scr, const LAS float* shv, int lane) {
    const int rsub = lane >> 3, c4 = lane & 7;
#pragma unroll
    for (int i = 0; i < 8; ++i) { const int kk = 8 * i + rsub; f32x4 x = v[i]; if (it.ksc) x = x * it.ksc[it.k0 + kk]; LAS float* d = scr + kk * 33 + 4 * c4; d[0] = x[0]; d[1] = x[1]; d[2] = x[2]; d[3] = x[3]; }
    LDS_WAIT(); asm volatile("" ::: "memory");
    if (it.bias != nullptr && it.n0 >= 0) {
        const int col = lane & 31, kh = lane >> 5;
        const LAS float* sh = shv + it.shoff + it.k0 + 32 * kh;
        float b0 = 0.f, b1 = 0.f, b2 = 0.f;
#pragma unroll 8
        for (int kk = 0; kk < 32; ++kk) { const float wv = scr[(32 * kh + kk) * 33 + col]; b0 += sh[kk] * wv; b1 += sh[1024 + kk] * wv; b2 += sh[2048 + kk] * wv; }
        b0 += __shfl_xor(b0, 32); b1 += __shfl_xor(b1, 32); b2 += __shfl_xor(b2, 32);
        if (lane < 32) { float* bp = it.bias + it.n0 + col; atomicAdd(bp, b0); atomicAdd(bp + it.bstride, b1); atomicAdd(bp + 2 * it.bstride, b2); }
    }
    const int c = lane & 7;
#pragma unroll
    for (int j = 0; j < 4; ++j) { const int rho = (lane >> 3) + 8 * j; const LAS float* sp = scr + (8 * c) * 33 + perm_off(it.pt, rho);
        u32x4 o; o.x = pk2(sp[0 * 33], sp[1 * 33]); o.y = pk2(sp[2 * 33], sp[3 * 33]); o.z = pk2(sp[4 * 33], sp[5 * 33]); o.w = pk2(sp[6 * 33], sp[7 * 33]);
        *(GAS u32x4*)(unsigned long long)(uintptr_t)(it.WT + (size_t)(it.drow0 + rho) * it.ldt + it.dk0 + 8 * c) = o; }
    LDS_WAIT(); asm volatile("" ::: "memory");
}
__device__ __forceinline__ void gemv3_item(const float* W, int ldw, int ncols, int n0, const LAS float* vec, LAS float* red, float* o0, float* o1, float* o2, const float* addb, int wave, int lane) {
    const int n = n0 + 4 * (lane & 15), rsub = lane >> 4; const bool ok = n < ncols;
    f32x4 a0 = (f32x4){0.f, 0.f, 0.f, 0.f}, a1 = a0, a2 = a0;
    const float* wp = W + (size_t)(128 * wave + rsub) * ldw + (ok ? n : n0);
#pragma unroll 16
    for (int it = 0; it < 32; ++it) { const f32x4 wv = gldf4(wp + (size_t)(4 * it) * ldw); const int k = 128 * wave + 4 * it + rsub; a0 += wv * vec[k]; a1 += wv * vec[1024 + k]; a2 += wv * vec[2048 + k]; }
#pragma unroll
    for (int i = 0; i < 4; ++i) { a0[i] += __shfl_xor(a0[i], 16); a0[i] += __shfl_xor(a0[i], 32); a1[i] += __shfl_xor(a1[i], 16); a1[i] += __shfl_xor(a1[i], 32); a2[i] += __shfl_xor(a2[i], 16); a2[i] += __shfl_xor(a2[i], 32); }
    if (lane < 16) { *(LAS f32x4*)(red + (wave * 3 + 0) * 64 + 4 * lane) = a0; *(LAS f32x4*)(red + (wave * 3 + 1) * 64 + 4 * lane) = a1; *(LAS f32x4*)(red + (wave * 3 + 2) * 64 + 4 * lane) = a2; }
    __syncthreads();
    if (wave < 3) { float sacc = 0.f; const int nn = n0 + lane;
#pragma unroll
        for (int k = 0; k < 8; ++k) sacc += red[(k * 3 + wave) * 64 + lane];
        const bool ok2 = nn < ncols;
        if (addb && ok2) sacc += addb[nn];
        float* op = wave == 0 ? o0 : (wave == 1 ? o1 : o2);
        if (ok2) op[nn] = sacc; }
    __syncthreads();
}

#define XB_TMO      128
#define XB_XCNT(j)  (256  + 64 * (j))
#define XB_XSUB(j)  (1280 + 64 * (j))
#define XB_XGEN(j)  (2304 + 64 * (j))
#define XB_TOP      3328
#define XB_TOPGEN   3392
#define XCD_BAR_WORDS 3456
#define XB_SPIN_CAP (1u << 18)
__device__ __forceinline__ unsigned xb_ld(unsigned* p)              { return __hip_atomic_load(p, __ATOMIC_RELAXED, __HIP_MEMORY_SCOPE_AGENT); }
__device__ __forceinline__ unsigned xb_add(unsigned* p, unsigned v) { return __hip_atomic_fetch_add(p, v, __ATOMIC_RELAXED, __HIP_MEMORY_SCOPE_AGENT); }
__device__ __forceinline__ unsigned xb_xcc_id() { return (unsigned)__builtin_amdgcn_s_getreg((3 << 11) | 20) & 0xFu; }
#define XB_SPIN(cond, bar) do { unsigned _sp = 0; while (cond) { __builtin_amdgcn_s_sleep(1); \
    if ((++_sp & 255u) == 0u) { if (xb_ld(&(bar)[XB_TMO])) break; if (_sp > XB_SPIN_CAP) { atomicAdd(&(bar)[XB_TMO], 1u); break; } } } } while (0)
struct XcdBarrier { unsigned* bar; unsigned x; volatile LAS unsigned* st; };
__device__ __forceinline__ XcdBarrier xcd_barrier_post(unsigned* bar, volatile LAS unsigned* st, int tid) {
    XcdBarrier b; b.bar = bar; b.x = xb_xcc_id(); b.st = st;
    if (tid == 0) (void)xb_add(&bar[XB_XCNT(b.x)], 1u);
    return b;
}
__device__ __forceinline__ void xcd_barrier_complete(unsigned* bar, unsigned x, unsigned& nloc, unsigned& nx) {
    const unsigned G = gridDim.x * gridDim.y * gridDim.z;
    unsigned sum, cnt, mine, sp = 0u;
    for (;;) {
        sum = 0u; cnt = 0u; mine = 0u;
#pragma unroll
        for (unsigned j = 0; j < 16; ++j) { const unsigned c = xb_ld(&bar[XB_XCNT(j)]); sum += c; cnt += (c > 0u) ? 1u : 0u; mine = (j == x) ? c : mine; }
        if (sum == G) break;
        __builtin_amdgcn_s_sleep(1);
        if ((++sp & 255u) == 0u) { if (xb_ld(&bar[XB_TMO])) break; if (sp > XB_SPIN_CAP) { atomicAdd(&bar[XB_TMO], 1u); break; } }
    }
    nloc = mine > 0u ? mine : 1u; nx = cnt > 0u ? cnt : 1u;
}
__device__ __forceinline__ void xcd_barrier(const XcdBarrier& b0, int tid) {
    asm volatile("s_waitcnt vmcnt(0)" ::: "memory");
    __syncthreads();
    if (tid == 0) {
        XcdBarrier b; b.bar = launder(b0.bar); b.x = xb_xcc_id(); b.st = b0.st;
        unsigned* bar = b.bar;
        __builtin_amdgcn_s_waitcnt(0);
        unsigned nloc = b.st[0], nx = b.st[1];
        if (nloc == 0u) { xcd_barrier_complete(bar, b.x, nloc, nx); b.st[0] = nloc; b.st[1] = nx; }
        const unsigned old = xb_add(&bar[XB_XSUB(b.x)], 1u);
        const unsigned gen = old / nloc;
        if (old + 1u == (gen + 1u) * nloc) {
            __builtin_amdgcn_fence(__ATOMIC_RELEASE, "agent");
            asm volatile("s_waitcnt vmcnt(0)" ::: "memory");
            const unsigned og = xb_add(&bar[XB_TOP], 1u);
            const unsigned tg = og / nx;
            if (og + 1u == (tg + 1u) * nx) xb_add(&bar[XB_TOPGEN], 1u);
            else XB_SPIN(xb_ld(&bar[XB_TOPGEN]) == tg, bar);
            __builtin_amdgcn_fence(__ATOMIC_ACQUIRE, "agent");
            xb_add(&bar[XB_XGEN(b.x)], 1u);
            asm volatile("s_waitcnt vmcnt(0)" ::: "memory");
        } else {
            XB_SPIN(xb_ld(&bar[XB_XGEN(b.x)]) == gen, bar);
            __builtin_amdgcn_fence(__ATOMIC_ACQUIRE, "agent");
            asm volatile("s_waitcnt vmcnt(0)" ::: "memory");
        }
    }
    __syncthreads();
}

struct Args { const float* in[32]; float* out; unsigned char* ws; int ph_lo, ph_hi; };
enum { I_XP = 0, I_XS, I_CDK, I_CDV, I_CCKV, I_CKPE, I_C, I_CCTX, I_MODW, I_MODB, I_N1G, I_WIN, I_CDW, I_CB, I_CNG, I_WCO, I_DQN, I_DKN, I_DLAM, I_DSUB, I_WDO,
       I_QAN, I_KVAN, I_WUQ, I_WUKV, I_MQN, I_MKN, I_WMO, I_WOUT, I_N2G, I_WUP, I_WDOWN };
constexpr int NPHASES = 18;

#define TAB_OFF (LDSCTL_OFF + 256)
__device__ __forceinline__ const float* inp(LAS unsigned char* lds, int i) {
    int i2 = i; asm volatile("" : "+s"(i2));
    const unsigned long long v = ((volatile LAS unsigned long long*)(lds + TAB_OFF))[i2];
    const unsigned lo = __builtin_amdgcn_readfirstlane((unsigned)v), hi = __builtin_amdgcn_readfirstlane((unsigned)(v >> 32));
    return (const float*)(GAS const float*)(((unsigned long long)hi << 32) | lo);
}

__device__ __forceinline__ void convert_layer(LAS unsigned char* lds, unsigned char* ws, int l, int it_lo, int it_hi, bool do_cache, int gw, int NGW, int gtid, int NGT, int lane, int wave) {
    LAS float* scr = (LAS float*)(lds + wave * 8448);
    LAS float* shv = (LAS float*)(lds + 67584);
    { const float* MODl = (const float*)(ws + WS_MOD) + (size_t)l * 3 * 6144; const int tid_ = wave * 64 + lane;
      __syncthreads();
      for (int k = tid_; k < 6144; k += 512) { const int m = k / 3072, r2 = k - 3072 * m, j = r2 >> 10, kk = r2 & 1023; shv[k] = MODl[j * 6144 + (m ? 3072 : 0) + kk]; }
      __syncthreads(); }
    constexpr int I1 = 200 * 16, I2A = 24 * 6, I2B = 32 * 4, I4 = 32 * 24, I5 = 32 * 16, I6 = 128 * 16, I7 = 32 * 64;
    constexpr int NITEMS = I1 + I2A + I2B + I4 + I5 + I6 + I7;
    if (it_hi > NITEMS) it_hi = NITEMS;
#define TR_DECODE(IT_, itidx) do { \
        int r = (itidx); \
        const float* W; const float* ksc = nullptr; bf16_t* WT; int ldw, k0, n0, ldt, drow0, dk0, pt = 1; float* bias_ = nullptr; int bstride_ = 0, shoff_ = 0; \
        if (r < I1) { const int kb = r / 200, db = r - 200 * kb; const int pn = db >> 3, bj = (db >> 2) & 1, wc = db & 3; \
            if (pn < 4) n0 = bj * 512 + 128 * pn + 32 * wc; \
            else if (pn < 8) { n0 = (pn < 6 ? 1024 : 1536) + 256 * ((pn - 4) & 1) + 64 * wc + 32 * bj; pt = 0; } \
            else if (pn < 10) n0 = 2048 + 256 * (pn - 8) + 128 * bj + 32 * wc; \
            else if (pn == 10) n0 = 2560 + 128 * bj + 32 * wc; \
            else if (pn == 11) n0 = bj == 0 ? 2816 + 32 * wc : (wc == 0 ? 3200 : -1); \
            else if (pn == 12) n0 = 2944 + 128 * bj + 32 * wc; \
            else n0 = 3232 + 256 * (pn - 13) + 128 * bj + 32 * wc; \
            W = inp(lds, I_WIN) + (size_t)l * 1024 * NIN; ldw = NIN; k0 = 64 * kb; WT = (bf16_t*)(ws + WS_BT1); ldt = 1024; drow0 = 32 * db; dk0 = 64 * kb; bias_ = (float*)(ws + WS_BIAS1) + (size_t)l * 3 * NIN; bstride_ = NIN; shoff_ = 0; } \
        else if ((r -= I1) < I2A) { const int kb = r / 24, blk = r - 24 * kb; const int h = blk / 3, part = blk - 3 * h; \
            W = inp(lds, I_WUQ) + (size_t)l * 384 * 768; ldw = 768; k0 = 64 * kb; n0 = 96 * h + 32 * part; WT = (bf16_t*)(ws + WS_BT2A); ldt = 384; drow0 = 32 * blk; dk0 = 64 * kb; pt = part == 2 ? 2 : 0; ksc = inp(lds, I_QAN) + l * 384; } \
        else if ((r -= I2A) < I2B) { const int kb = r >> 5, db = r & 31; const int pn = db >> 3, bj = (db >> 2) & 1, wc = db & 3; \
            if (pn < 2) { n0 = 128 * (4 * pn + wc) + 32 * bj; pt = 0; } else { n0 = 128 * (4 * (pn - 2) + 2 * bj + (wc >> 1)) + 64 + 32 * (wc & 1); pt = 1; } \
            W = inp(lds, I_WUKV) + (size_t)l * 256 * 1024; ldw = 1024; k0 = 64 * kb; WT = (bf16_t*)(ws + WS_BT2B); ldt = 256; drow0 = 32 * db; dk0 = 64 * kb; ksc = inp(lds, I_KVAN) + l * 256; } \
        else if ((r -= I2B) < I4) { const int kb = r >> 5, db = r & 31; const int sg = kb >> 3; \
            W = inp(lds, sg == 0 ? I_WCO : (sg == 1 ? I_WDO : I_WMO)) + (size_t)l * 512 * 1024; ldw = 1024; k0 = 64 * (kb & 7); n0 = 32 * db; WT = (bf16_t*)(ws + (l == 0 ? WS_BT4 : WS_BT4B)); ldt = 1536; drow0 = 32 * db; dk0 = 64 * kb; } \
        else if ((r -= I4) < I5) { const int kb = r >> 5, db = r & 31; W = inp(lds, I_WOUT) + (size_t)l * 1024 * 1024; ldw = 1024; k0 = 64 * kb; n0 = 32 * db; WT = (bf16_t*)(ws + (l == 0 ? WS_BT5 : WS_BT5B)); ldt = 1024; drow0 = 32 * db; dk0 = 64 * kb; } \
        else if ((r -= I5) < I6) { const int kb = r >> 7, db = r & 127; W = inp(lds, I_WUP) + (size_t)l * 1024 * 4096; ldw = 4096; k0 = 64 * kb; n0 = 32 * db; WT = (bf16_t*)(ws + (l == 0 ? WS_BT6 : WS_BT6B)); ldt = 1024; drow0 = 32 * db; dk0 = 64 * kb; bias_ = (float*)(ws + WS_BIAS2) + (size_t)l * 3 * 4096; bstride_ = 4096; shoff_ = 3072; } \
        else { r -= I6; const int kb = r >> 5, db = r & 31; W = inp(lds, I_WDOWN) + (size_t)l * 4096 * 1024; ldw = 1024; k0 = 64 * kb; n0 = 32 * db; WT = (bf16_t*)(ws + (l == 0 ? WS_BT7 : WS_BT7B)); ldt = 4096; drow0 = 32 * db; dk0 = 64 * kb; } \
        IT_.W = W; IT_.ksc = ksc; IT_.WT = WT; IT_.ldw = ldw; IT_.k0 = k0; IT_.n0 = n0; IT_.ldt = ldt; IT_.drow0 = drow0; IT_.dk0 = dk0; IT_.pt = pt; IT_.bias = bias_; IT_.bstride = bstride_; IT_.shoff = shoff_; } while (0)
    {
        int it = it_lo + gw;
        TrItem A, B; f32x4 va[8], vb[8];
        if (it < it_hi) { TR_DECODE(A, it); tr_load(A, va, lane); }
        while (it < it_hi) {
            const bool hasB = it + NGW < it_hi;
            if (hasB) { TR_DECODE(B, it + NGW); tr_load(B, vb, lane); }
            tr_process(A, va, scr, shv, lane);
            it += NGW;
            if (!hasB) break;
            const bool hasA = it + NGW < it_hi;
            if (hasA) { TR_DECODE(A, it + NGW); tr_load(A, va, lane); }
            tr_process(B, vb, scr, shv, lane);
            it += NGW;
        }
    }
#undef TR_DECODE
    if (!do_cache) return;
    bf16_t* KD = (bf16_t*)(ws + WS_KD); bf16_t* VD = (bf16_t*)(ws + WS_VD); bf16_t* CKVA = (bf16_t*)(ws + WS_CKVA);
    float* KPER = (float*)(ws + WS_KPER); float* KPESS = (float*)(ws + WS_KPESS);
    { const float* cdk = inp(lds, I_CDK); const float* cdv = inp(lds, I_CDV);
    for (int ci = gtid; ci < 512 * 64; ci += NGT) {
        const int row = ci >> 6, c8 = ci & 63, b = row >> 8, j = row & 255;
        const size_t src = ((size_t)(b * 2 + l) * 256 + j) * 512 + 8 * c8; const size_t dst = (size_t)(4096 + b * 2304 + j) * 512 + 8 * c8;
        { const f32x4 x0 = *(const f32x4*)(cdk + src), x1 = *(const f32x4*)(cdk + src + 4);
          u32x4 w; w.x = pk2(x0[0], x0[1]); w.y = pk2(x0[2], x0[3]); w.z = pk2(x1[0], x1[1]); w.w = pk2(x1[2], x1[3]); *(u32x4*)(KD + dst) = w; }
        { const f32x4 x0 = *(const f32x4*)(cdv + src), x1 = *(const f32x4*)(cdv + src + 4);
          u32x4 w; w.x = pk2(x0[0], x0[1]); w.y = pk2(x0[2], x0[3]); w.z = pk2(x1[0], x1[1]); w.w = pk2(x1[2], x1[3]); *(u32x4*)(VD + dst) = w; }
    } }
    { const float* cckv = inp(lds, I_CCKV); const float* gk = inp(lds, I_KVAN) + l * 256;
    for (int ci = gtid; ci < 512 * 32; ci += NGT) {
        const int row = ci >> 5, c8 = ci & 31, b = row >> 8, j = row & 255;
        const size_t src = ((size_t)(b * 2 + l) * 256 + j) * 256 + 8 * c8;
        const float* g = gk + 8 * c8;
        const f32x4 x0 = *(const f32x4*)(cckv + src) / *(const f32x4*)g, x1 = *(const f32x4*)(cckv + src + 4) / *(const f32x4*)(g + 4);
        u32x4 w; w.x = pk2(x0[0], x0[1]); w.y = pk2(x0[2], x0[3]); w.z = pk2(x1[0], x1[1]); w.w = pk2(x1[2], x1[3]);
        *(u32x4*)(CKVA + (size_t)(8192 + row) * 256 + 8 * c8) = w;
    } }
    { const float* ckpe = inp(lds, I_CKPE);
    for (int row = gtid; row < 512; row += NGT) {
        const int b = row >> 8, j = row & 255; const float* src = ckpe + ((size_t)(b * 2 + l) * 256 + j) * 32; float ss = 0.f;
#pragma unroll
        for (int q = 0; q < 8; ++q) { const f32x4 x = *(const f32x4*)(src + 4 * q); *(f32x4*)(KPER + (size_t)(8192 + row) * 32 + 4 * q) = x; ss += sum4(x * x); }
        KPESS[8192 + row] = ss;
    } }
}

__global__ void __launch_bounds__(512, 2) mk_fwd(Args a) {
    extern __shared__ __attribute__((aligned(16))) unsigned char lds_raw[];
    LAS unsigned char* lds = (LAS unsigned char*)lds_raw;
    const int wave0 = __builtin_amdgcn_readfirstlane(threadIdx.x >> 6);
    const int G = gridDim.x, bx = blockIdx.x;
    const int vcu = (G % 8 == 0) ? (bx % 8) * (G / 8) + bx / 8 : bx;
    const int NGW = G * 8, NGT = G * 512;
#define PH_VARS const int tid = mk_tid(wave0); const int lane = tid & 63, wave = __builtin_amdgcn_readfirstlane(tid >> 6); const int gw = vcu * 8 + wave, gtid = vcu * 512 + tid; (void)lane; (void)gw; (void)gtid;
    { const int tid = mk_tid(wave0);
    for (int u = tid; u < (LDS_BYTES - LDSCTL_OFF) / 4; u += 512) ((LAS unsigned*)(lds + LDSCTL_OFF))[u] = 0u;
    __syncthreads();
    if (tid == 0) {
        LAS unsigned long long* tab = (LAS unsigned long long*)(lds + TAB_OFF);
#define TAB_SET(i) tab[i] = (unsigned long long)(uintptr_t)a.in[i]
        TAB_SET(0); TAB_SET(1); TAB_SET(2); TAB_SET(3); TAB_SET(4); TAB_SET(5); TAB_SET(6); TAB_SET(7); TAB_SET(8); TAB_SET(9); TAB_SET(10); TAB_SET(11); TAB_SET(12); TAB_SET(13); TAB_SET(14); TAB_SET(15);
        TAB_SET(16); TAB_SET(17); TAB_SET(18); TAB_SET(19); TAB_SET(20); TAB_SET(21); TAB_SET(22); TAB_SET(23); TAB_SET(24); TAB_SET(25); TAB_SET(26); TAB_SET(27); TAB_SET(28); TAB_SET(29); TAB_SET(30); TAB_SET(31);
#undef TAB_SET
    }
    __syncthreads(); }
    volatile LAS unsigned* MISC = (volatile LAS unsigned*)(lds + LDSCTL_OFF);
    if (mk_tid(wave0) == 0) __hip_atomic_store((unsigned*)(a.ws + WS_CTL) + XCCTAB_WORD + blockIdx.x, xb_xcc_id() + 1u, __ATOMIC_RELAXED, __HIP_MEMORY_SCOPE_AGENT);
    XcdBarrier bar; bar.bar = (unsigned*)(a.ws + WS_CTL) + 1024; bar.x = 0; bar.st = nullptr;
#if !MK_PER_PHASE
    bar = xcd_barrier_post((unsigned*)(a.ws + WS_CTL) + 1024, MISC + 8, mk_tid(wave0));
#define GRID_BAR() xcd_barrier(bar, mk_tid(wave0))
#else
#define GRID_BAR() do {} while (0)
#endif
#if MK_PER_PHASE
    const int lo = a.ph_lo, hi = a.ph_hi;
#else
    constexpr int lo = 0, hi = NPHASES;
#endif
#ifndef PHMASK
#define PHMASK 0xFFFFFFFFu
#endif
#ifndef SPIN_MASK
#define SPIN_MASK 0u
#endif
    unsigned long long t_prev = 0; unsigned long long t_acc = 0;
    if (SPIN_MASK) t_prev = __builtin_amdgcn_s_memrealtime();
#define STAMP(k) do { if (SPIN_MASK) { const unsigned long long t_now = __builtin_amdgcn_s_memrealtime(); if ((SPIN_MASK >> ((k) < 2 ? (k) : 2 + (((k) - 2) & 7))) & 1u) t_acc += t_now - t_prev; t_prev = t_now; } } while (0)
#define SUBSTAMP(bit) do { if (SPIN_MASK) { const unsigned long long t_now = __builtin_amdgcn_s_memrealtime(); if ((SPIN_MASK >> (bit)) & 1u) t_acc += t_now - t_prev; t_prev = t_now; } } while (0)
#define IN(k) (((PHMASK >> ((k) < 2 ? (k) : 2 + (((k) - 2) & 7))) & 1u) && lo <= (k) && (k) < hi)
#define SEAM(k) do { if (lo <= (k) && (k) + 1 < hi) GRID_BAR(); STAMP(k); } while (0)

    if (IN(0)) {
        PH_VARS
        unsigned char* ws = launder(a.ws);
        float* MOD = (float*)(ws + WS_MOD);
        LAS float* vec = (LAS float*)(lds + 0);
        LAS float* red = (LAS float*)(lds + 12288);
        { const float* cctx = inp(lds, I_CCTX); const float* cc = inp(lds, I_C);
          for (int k = tid; k < 3072; k += 512) { const int j = k >> 10, kk = k & 1023; const float x = j == 0 ? cctx[kk] : cc[(j - 1) * 1024 + kk]; vec[k] = x * sigmoidf_(x); } }
        __syncthreads();
        { const float* modw = inp(lds, I_MODW); const float* modb = inp(lds, I_MODB);
          for (int it = vcu; it < 192; it += G) { const int l = it / 96, n0 = 64 * (it % 96);
            gemv3_item(modw + (size_t)l * 1024 * 6144, 6144, 6144, n0, vec, red, MOD + (l * 3 + 0) * 6144, MOD + (l * 3 + 1) * 6144, MOD + (l * 3 + 2) * 6144, modb + l * 6144, wave, lane); } }
        __syncthreads();
        { float* b1 = (float*)(ws + WS_BIAS1); float* b2 = (float*)(ws + WS_BIAS2);
          for (int i = gtid; i < 2 * 3 * NIN; i += NGT) b1[i] = 0.f;
          for (int i = gtid; i < 2 * 3 * 4096; i += NGT) b2[i] = 0.f; }
        float* cosD = (float*)(ws + WS_TAB); float* sinD = cosD + 1024; float* cosM = cosD + 2048; float* sinM = cosD + 2560;
        for (int i = gtid; i < 1024 + 512; i += NGT) {
            if (i < 1024) { const int pos = i >> 4, f = i & 15; const float inv = powf(10000.0f, -(float)f / 16.0f), ang = (float)pos * inv; cosD[i] = cosf(ang); sinD[i] = sinf(ang); }
            else { const int k = i - 1024, pos = k >> 3, f = k & 7; const float inv = powf(10000.0f, -(float)f / 8.0f), ang = (float)pos * inv; cosM[k] = cosf(ang); sinM[k] = sinf(ang); }
        }
    }
    SEAM(0);
    if (IN(1)) {
        PH_VARS
        unsigned char* ws = launder(a.ws);
        float* MOD = (float*)(ws + WS_MOD); float* BIAS1 = (float*)(ws + WS_BIAS1); float* BIAS2 = (float*)(ws + WS_BIAS2);
        bf16_t* XN = (bf16_t*)(ws + WS_XN); float* XSS = (float*)(ws + WS_XSS);
        LAS float* vec = (LAS float*)(lds + 0); LAS float* red = (LAS float*)(lds + 12288);
        convert_layer(lds, ws, 0, 0, 1 << 30, true, gw, NGW, gtid, NGT, lane, wave);
        { const float* xp = inp(lds, I_XP); const float* xs = inp(lds, I_XS); const float* g = inp(lds, I_N1G);
        for (int rb = gw; rb < MROWS; rb += 4 * NGW) {
            f32x4 x[4][4];
#pragma unroll
            for (int q = 0; q < 4; ++q) { const int row = rb + q * NGW; if (row < MROWS) { const float* xr = row < 4096 ? xp + (size_t)row * 1024 : xs + (size_t)(row - 4096) * 1024;
#pragma unroll
                for (int j = 0; j < 4; ++j) x[q][j] = *(const f32x4*)(xr + 256 * j + 4 * lane); } }
#pragma unroll
            for (int q = 0; q < 4; ++q) { const int row = rb + q * NGW; if (row < MROWS) {
                const int cond = row < 4096 ? 0 : 1 + ((row - 4096) >> 11);
                const float* sc = MOD + (0 * 3 + cond) * 6144 + 1024;
                float ss = 0.f;
#pragma unroll
                for (int j = 0; j < 4; ++j) { const int col = 256 * j + 4 * lane; ss += sum4(x[q][j] * x[q][j]);
                    const f32x4 y = x[q][j] * *(const f32x4*)(g + col) * (*(const f32x4*)(sc + col) + 1.0f); u32x2 w; w.x = pk2(y[0], y[1]); w.y = pk2(y[2], y[3]); *(u32x2*)(XN + (size_t)row * 1024 + col) = w; }
                ss = wave_sum(ss);
                if (lane < 16) XSS[(size_t)row * 16 + lane] = lane == 0 ? ss : 0.f;
            } }
        } }
    }
    SEAM(1);

    for (int l = 0; l < 2; ++l) {
        const int P = 2 + 8 * l;
        if (IN(P + 0)) {
            unsigned char* ws = launder(a.ws);
            pg8::Gemm g{(const bf16_t*)(ws + WS_XN), (const bf16_t*)(ws + WS_BT1), MROWS, 6144, 1024}; pg8::StaticOrder S; S.init(MROWS, 6144, G, launder_s(bx));
            EpiIn E{ws, a.out, inp(lds, I_DQN) + l * 64, inp(lds, I_DKN) + l * 64, l, 0};
            pg8::gemm_phase<EpiIn, true>(lds, g, S, E, wave0);
        }
        SEAM(P + 0);
        if (IN(P + 1)) {
            { unsigned char* ws = launder(a.ws);
              pg8::Gemm g{(const bf16_t*)(ws + WS_XN), (const bf16_t*)(ws + WS_BT1) + (size_t)6144 * 1024, MROWS, 256, 1024}; pg8::StaticOrder S; S.init(MROWS, 256, G, (launder_s(bx) + 24) % G);
              EpiIn E{ws, a.out, inp(lds, I_DQN) + l * 64, inp(lds, I_DKN) + l * 64, l, 24};
              pg8::gemm_phase<EpiIn, false>(lds, g, S, E, wave0); }
#if !defined(P2SUB) || P2SUB == 0
            { unsigned char* ws = launder(a.ws);
              pg8::Gemm g{(const bf16_t*)(ws + WS_CQ), (const bf16_t*)(ws + WS_BT2A), MROWS, 768, 384}; pg8::StaticOrder S; S.init(MROWS, 768, G, launder_s(bx));
              EpiQM E{ws, inp(lds, I_MQN) + l * 96};
              pg8::gemm_phase<EpiQM, false>(lds, g, S, E, wave0); }
            SUBSTAMP(10);
#endif
#if !defined(P2SUB) || P2SUB == 1
            { unsigned char* ws = launder(a.ws);
              pg8::Gemm g{(const bf16_t*)(ws + WS_CKVA), (const bf16_t*)(ws + WS_BT2B), KROWS, 1024, 256}; pg8::StaticOrder S; S.init(KROWS, 1024, G, (launder_s(bx) + 160) % G);
              EpiKV E{ws, a.out, inp(lds, I_MKN) + l * 96, inp(lds, I_KVAN) + l * 256, l};
              pg8::gemm_phase<EpiKV, false>(lds, g, S, E, wave0); }
            SUBSTAMP(11);
#endif
#if !defined(P2SUB) || P2SUB == 2
            { unsigned char* ws = launder(a.ws);
              const float* dw = inp(lds, I_CDW) + (size_t)l * 31 * 512; const float* cb = inp(lds, I_CB) + l * 512; const float* cg = inp(lds, I_CNG) + l * 512;
              for (int it = vcu; it < 256; it += G) conv_item(lds, (const bf16_t*)(ws + WS_U), dw, cb, cg, (bf16_t*)(ws + WS_ACAT), it, wave0); }
            SUBSTAMP(12);
#endif
        }
        SEAM(P + 1);
        if (IN(P + 2)) {
            PH_VARS
            unsigned char* ws = launder(a.ws);
            const bf16_t* QD = (const bf16_t*)(ws + WS_QD); const bf16_t* KD = (const bf16_t*)(ws + WS_KD); const bf16_t* VD = (const bf16_t*)(ws + WS_VD);
            const bf16_t* QM = (const bf16_t*)(ws + WS_QM); const bf16_t* KM = (const bf16_t*)(ws + WS_KM); const bf16_t* VM = (const bf16_t*)(ws + WS_VM);
            const float* QSS = (const float*)(ws + WS_QSS); const float* CQP = (const float*)(ws + WS_CQP); bf16_t* ACAT = (bf16_t*)(ws + WS_ACAT);
            const float lam_init = l == 0 ? 0.2f : 0.35550906759f;
            float lam;
            { const float* lp = inp(lds, I_DLAM) + l * 256; float s1 = 0.f, s2 = 0.f;
#pragma unroll 8
              for (int i = 0; i < 64; ++i) { s1 += lp[i] * lp[64 + i]; s2 += lp[128 + i] * lp[192 + i]; }
              lam = __expf(s1) - __expf(s2) + lam_init; }
            const float* subln = inp(lds, I_DSUB) + l * 128;
            for (int c = vcu; c < 256; c += G) {
                if (c < 128) {
                    { const int b = c >> 6, h = (c >> 4) & 3, qb = c & 15; diff_unit(lds, QD, KD, VD, ACAT, 4096 + 2048 * b + 128 * qb, 4096 + 2304 * b, 36, h, lam, 1.0f - lam_init, subln, (qb * 36) >> 4, wave0); }
                    SUBSTAMP(13);
                    { const int b = c >> 3, h = c & 7; mla_unit(lds, QM, QSS, CQP, KM, VM, ACAT, 256 * b, 256 * b, 4, h, 0, wave0); }
                    SUBSTAMP(14);
                } else {
                    const int i = c - 128;
                    { const int b = i >> 6, h = (i >> 3) & 7, qb = i & 7; mla_unit(lds, QM, QSS, CQP, KM, VM, ACAT, 4096 + 2048 * b + 256 * qb, 4096 + 2304 * b, 36, h, (qb * 36) >> 3, wave0); }
                    SUBSTAMP(15);
                    { const int b = i >> 3, h = (i >> 1) & 3, qb = i & 1; diff_unit(lds, QD, KD, VD, ACAT, 256 * b + 128 * qb, 256 * b, 4, h, lam, 1.0f - lam_init, subln, 2 * qb, wave0); }
                }
            }
        }
        SEAM(P + 2);
        if (IN(P + 3)) {
            unsigned char* ws = launder(a.ws);
            pg8::Gemm g{(const bf16_t*)(ws + WS_ACAT), (const bf16_t*)(ws + (l == 0 ? WS_BT4 : WS_BT4B)), MROWS, 1024, 1536}; pg8::StaticOrder S; S.init(MROWS, 1024, G, launder_s(bx), 1);
            EpiMerge E{ws, 8192 + (l * 3 + 0) * 1024};
            pg8::gemm_phase<EpiMerge, false>(lds, g, S, E, wave0);
            if (l == 0 && bx >= 128) { PH_VARS convert_layer(lds, ws, 1, 0, 4424, true, (bx - 128) * 8 + wave, 1024, (bx - 128) * 512 + tid, 65536, lane, wave); }
        }
        SEAM(P + 3);
        if (IN(P + 4)) {
            unsigned char* ws = launder(a.ws);
            pg8::Gemm g{(const bf16_t*)(ws + WS_MG), (const bf16_t*)(ws + (l == 0 ? WS_BT5 : WS_BT5B)), MROWS, 1024, 1024}; pg8::StaticOrder S; S.init(MROWS, 1024, G, launder_s(bx), 1);
            EpiRes E{l == 0 ? inp(lds, I_XP) : a.out, l == 0 ? inp(lds, I_XS) : a.out + (size_t)4096 * 1024, a.out, ws, l * 3 * 6144 + 2048, inp(lds, I_N2G) + l * 1024, l * 3 * 6144 + 4096, 8192 + (l * 3 + 1) * 1024};
            pg8::gemm_phase<EpiRes, false>(lds, g, S, E, wave0);
            if (l == 0 && bx >= 128) { PH_VARS convert_layer(lds, ws, 1, 4424, 1 << 30, false, (bx - 128) * 8 + wave, 1024, (bx - 128) * 512 + tid, 65536, lane, wave); }
        }
        SEAM(P + 4);
        if (IN(P + 5)) {
            unsigned char* ws = launder(a.ws);
            pg8::Gemm g{(const bf16_t*)(ws + WS_XN), (const bf16_t*)(ws + (l == 0 ? WS_BT6 : WS_BT6B)), MROWS, 4096, 1024}; pg8::StaticOrder S; S.init(MROWS, 4096, G, launder_s(bx));
            EpiUp E{ws, l};
            pg8::gemm_phase<EpiUp, true>(lds, g, S, E, wave0);
        }
        SEAM(P + 5);
        if (IN(P + 6)) {
            unsigned char* ws = launder(a.ws);
            pg8::Gemm g{(const bf16_t*)(ws + WS_R1), (const bf16_t*)(ws + (l == 0 ? WS_BT7 : WS_BT7B)), MROWS, 1024, 4096}; pg8::StaticOrder S; S.init(MROWS, 1024, G, launder_s(bx), 2);
            EpiRes E{a.out, a.out + (size_t)4096 * 1024, a.out, ws, l * 3 * 6144 + 5120, l == 0 ? inp(lds, I_N1G) + 1024 : nullptr, 3 * 6144 + 1024, 8192 + (l * 3 + 2) * 1024};
            pg8::gemm_phase<EpiRes, false>(lds, g, S, E, wave0);
        }
        if (l == 0) { if (lo <= P + 6 && P + 8 < hi) GRID_BAR(); STAMP(P + 6); }
    }
    STAMP(16);
    if (SPIN_MASK) { const unsigned long long t0 = __builtin_amdgcn_s_memrealtime(); while (__builtin_amdgcn_s_memrealtime() - t0 < t_acc) __builtin_amdgcn_s_sleep(8); }
#undef IN
#undef SEAM
}

extern "C" void kernel_launch(void* const* d_in, const int* in_sizes, int n_in, void* d_out, int out_size, void* d_ws, size_t ws_size, hipStream_t stream) {
    static int grid = 0;
    if (grid == 0) {
        if (n_in != 32 || out_size != 19136512 || ws_size < WS_END) { fprintf(stderr, "kernel_launch: unexpected shapes (n_in %d out %d ws %zu)\n", n_in, out_size, ws_size); grid = -1; return; }
        int dev = 0, cus = 0;
        if (hipGetDevice(&dev) != hipSuccess || hipDeviceGetAttribute(&cus, hipDeviceAttributeMultiprocessorCount, dev) != hipSuccess) { grid = -1; return; }
        if (hipFuncSetAttribute((const void*)mk_fwd, hipFuncAttributeMaxDynamicSharedMemorySize, LDS_BYTES) != hipSuccess) { fprintf(stderr, "kernel_launch: hipFuncSetAttribute failed\n"); grid = -1; return; }
        int per_cu = 0;
        if (hipOccupancyMaxActiveBlocksPerMultiprocessor(&per_cu, (const void*)mk_fwd, 512, LDS_BYTES) != hipSuccess || per_cu < 1) fprintf(stderr, "kernel_launch: occupancy query reports %d\n", per_cu);
        (void)hipGetLastError();
        grid = cus;
    }
    if (grid < 0) return;
    (void)hipMemsetAsync((char*)d_ws + WS_CTL, 0, CTL_ZERO_BYTES, stream);
    Args a{};
    for (int i = 0; i < 32; ++i) a.in[i] = (const float*)d_in[i];
    a.out = (float*)d_out; a.ws = (unsigned char*)d_ws;
#if MK_PER_PHASE
    for (int p = 0; p < NPHASES; ++p) { a.ph_lo = p; a.ph_hi = p + 1; hipLaunchKernelGGL(mk_fwd, dim3(grid), dim3(512), LDS_BYTES, stream, a); }
#else
    a.ph_lo = 0; a.ph_hi = NPHASES;
    hipLaunchKernelGGL(mk_fwd, dim3(grid), dim3(512), LDS_BYTES, stream, a);
#endif
}
```
